# Optimizing an MI355X kernel written in HIP

```python
import jax
import jax.numpy as jnp
from jax import lax
import numpy as np

D_MODEL = 2048
BATCH = 4
SEQ = 8192
DEPTH = 1

GRID_W = 64
CTX_LEN = 256

ATTN_HEADS = 16
ATTN_KV_HEADS = 4
ATTN_GROUP = ATTN_HEADS // ATTN_KV_HEADS
HEAD_DIM = 128
WINDOW = 128
BLOCK = 128
ROPE_BASE = 10000.0

MLSTM_HEADS = 8
MLSTM_QK_DIM = 128
MLSTM_V_DIM = 256
MLSTM_CHUNK = 128
N_DIRS = 2
FGATE_BIAS_LO = 3.0
FGATE_BIAS_HI = 6.0

D_FF = -(-8 * D_MODEL // (3 * 256)) * 256

NORM_EPS = 1e-6
N_MOD = 6

ATTN_Q_W = ATTN_HEADS * HEAD_DIM
ATTN_KV_W = ATTN_KV_HEADS * HEAD_DIM
MLSTM_QK_W = MLSTM_HEADS * MLSTM_QK_DIM
MLSTM_V_W = MLSTM_HEADS * MLSTM_V_DIM
N_GATE = N_DIRS * 2 * MLSTM_HEADS
KV_SIDE_SIZES = (ATTN_KV_W, ATTN_KV_W, MLSTM_QK_W, MLSTM_V_W, N_GATE)
Q_SIDE_SIZES = (ATTN_Q_W, MLSTM_QK_W, MLSTM_V_W, D_MODEL, D_MODEL)
N_KV_SIDE = sum(KV_SIDE_SIZES)
N_IN = N_KV_SIDE + sum(Q_SIDE_SIZES)

kernel_name = "hybrid_dit_gqa_mlstm_prefix"


def _split(p, sizes):
    idx = [int(i) for i in np.cumsum(sizes)[:-1]]
    return jnp.split(p, idx, axis=-1)


def rms_norm(x, g):
    xf = x.astype(jnp.float32)
    y = xf * lax.rsqrt(jnp.mean(xf * xf, axis=-1, keepdims=True) + NORM_EPS)
    return (y * g.astype(jnp.float32)).astype(x.dtype)


def modulate(h, shift, scale):
    return h * (1 + scale) + shift


def adaln_params(cvec, w, b, n_chunks):
    mod = jax.nn.silu(cvec) @ w[:, :n_chunks * D_MODEL] + b[:n_chunks * D_MODEL]
    return jnp.split(mod, n_chunks, axis=-1)


def _rope_1d(x, pos):
    half = x.shape[-1] // 2
    inv_freq = ROPE_BASE ** (-jnp.arange(half, dtype=jnp.float32) / half)
    ang = pos.astype(jnp.float32)[:, None] * inv_freq[None, :]
    cos = jnp.cos(ang)[:, None, :]
    sin = jnp.sin(ang)[:, None, :]
    x1 = x[..., :half].astype(jnp.float32)
    x2 = x[..., half:].astype(jnp.float32)
    return jnp.concatenate([x1 * cos - x2 * sin, x2 * cos + x1 * sin], axis=-1)


def rope_2d(x, rows, cols):
    half = x.shape[-1] // 2
    y = jnp.concatenate([_rope_1d(x[..., :half], rows), _rope_1d(x[..., half:], cols)], axis=-1)
    return y.astype(x.dtype)


def window_attention(q, k, v, kc, vc, sink):
    B, S = q.shape[:2]
    C = kc.shape[1]
    nb = S // BLOCK
    scale = HEAD_DIM ** -0.5
    qb = q.reshape(B, nb, BLOCK, ATTN_KV_HEADS, ATTN_GROUP, HEAD_DIM)

    def band(t):
        tp = jnp.pad(t, ((0, 0), (BLOCK, BLOCK), (0, 0), (0, 0)))
        tp = tp.reshape(B, nb + 2, BLOCK, ATTN_KV_HEADS, HEAD_DIM)
        return jnp.concatenate([tp[:, :-2], tp[:, 1:-1], tp[:, 2:]], axis=2)

    kb, vb = band(k), band(v)
    s_loc = jnp.einsum("bnqhgd,bnkhd->bhgnqk", qb, kb).astype(jnp.float32) * scale
    s_ctx = jnp.einsum("bnqhgd,bchd->bhgnqc", qb, kc).astype(jnp.float32) * scale
    qpos = jnp.arange(S).reshape(nb, BLOCK, 1)
    kpos = (jnp.arange(nb) * BLOCK - BLOCK)[:, None, None] + jnp.arange(3 * BLOCK)[None, None, :]
    valid = (jnp.abs(qpos - kpos) <= WINDOW) & (kpos >= 0) & (kpos < S)
    s_loc = jnp.where(valid, s_loc, -jnp.inf)
    sink_l = jnp.broadcast_to(sink.astype(jnp.float32).reshape(1, ATTN_KV_HEADS, ATTN_GROUP, 1, 1, 1),
                              s_loc.shape[:-1] + (1,))
    p = jax.nn.softmax(jnp.concatenate([s_loc, s_ctx, sink_l], axis=-1), axis=-1).astype(v.dtype)
    n_loc = 3 * BLOCK
    o = (jnp.einsum("bhgnqk,bnkhd->bnqhgd", p[..., :n_loc], vb)
         + jnp.einsum("bhgnqc,bchd->bnqhgd", p[..., n_loc:n_loc + C], vc))
    return o.reshape(B, S, ATTN_Q_W)


def context_attention(q, kc, vc, sink):
    B, C = q.shape[:2]
    qg = q.reshape(B, C, ATTN_KV_HEADS, ATTN_GROUP, HEAD_DIM)
    s = jnp.einsum("bqhgd,bkhd->bhgqk", qg, kc).astype(jnp.float32) * (HEAD_DIM ** -0.5)
    sink_l = jnp.broadcast_to(sink.astype(jnp.float32).reshape(1, ATTN_KV_HEADS, ATTN_GROUP, 1, 1),
                              s.shape[:-1] + (1,))
    p = jax.nn.softmax(jnp.concatenate([s, sink_l], axis=-1), axis=-1)[..., :C].astype(vc.dtype)
    return jnp.einsum("bhgqk,bkhd->bqhgd", p, vc).reshape(B, C, ATTN_Q_W)


def mlstm_chunk_states(k, v, logi, logf, state0):
    B, H, T, _ = k.shape
    N = T // MLSTM_CHUNK
    kc = k.reshape(B, H, N, MLSTM_CHUNK, MLSTM_QK_DIM)
    vc = v.reshape(B, H, N, MLSTM_CHUNK, MLSTM_V_DIM)
    b = jnp.cumsum(logf.reshape(B, H, N, MLSTM_CHUNK), axis=-1)
    b_end = b[..., -1]
    w = b_end[..., None] - b + logi.reshape(B, H, N, MLSTM_CHUNK)
    a = jnp.max(w, axis=-1)
    e = jnp.exp(w - a[..., None])
    c_loc = jnp.einsum("bhnl,bhnlk,bhnlv->bhnkv", e, kc, vc)
    n_loc = jnp.einsum("bhnl,bhnlk->bhnk", e, kc)

    def step(carry, xs):
        C, n, m = carry
        cl, nl, bl, al = xs
        m_new = jnp.maximum(bl + m, al)
        f_prev = jnp.exp(bl + m - m_new)
        f_loc = jnp.exp(al - m_new)
        C_new = f_prev[..., None, None] * C + f_loc[..., None, None] * cl
        n_new = f_prev[..., None] * n + f_loc[..., None] * nl
        return (C_new, n_new, m_new), (C, n, m)

    xs = tuple(jnp.moveaxis(t, 2, 0) for t in (c_loc, n_loc, b_end, a))
    final, starts = lax.scan(step, state0, xs)
    starts = tuple(jnp.moveaxis(t, 0, 2) for t in starts)
    return starts, final


def mlstm_chunk_outputs(q, k, v, logi, logf, starts):
    B, H, T, _ = q.shape
    N = T // MLSTM_CHUNK
    L = MLSTM_CHUNK
    qc = q.reshape(B, H, N, L, MLSTM_QK_DIM)
    kc = k.reshape(B, H, N, L, MLSTM_QK_DIM)
    vc = v.reshape(B, H, N, L, MLSTM_V_DIM)
    li = logi.reshape(B, H, N, L)
    b = jnp.cumsum(logf.reshape(B, H, N, L), axis=-1)
    C0, n0, m0 = starts
    order = jnp.arange(L)[:, None] >= jnp.arange(L)[None, :]
    w = jnp.where(order, b[..., :, None] - b[..., None, :] + li[..., None, :], -jnp.inf)
    inter = b + m0[..., None]
    m = jnp.maximum(inter, jnp.max(w, axis=-1))
    s = jnp.einsum("bhntk,bhnsk->bhnts", qc, kc) * jnp.exp(w - m[..., None])
    e_inter = jnp.exp(inter - m)
    num = (jnp.einsum("bhnts,bhnsv->bhntv", s, vc)
           + e_inter[..., None] * jnp.einsum("bhntk,bhnkv->bhntv", qc, C0))
    den = jnp.sum(s, axis=-1) + e_inter * jnp.einsum("bhntk,bhnk->bhnt", qc, n0)
    h = num / jnp.maximum(jnp.abs(den), jnp.exp(-m))[..., None]
    return h.reshape(B, H, T, MLSTM_V_DIM)


def _maybe_flip(t, rev):
    return jnp.flip(t, axis=2) if rev else t


def mlstm_mixer(q, k, v, g, kc, vc, gc, qc, b_gates):
    B = q.shape[0]
    H = MLSTM_HEADS
    scale = MLSTM_QK_DIM ** -0.5

    def heads(t, d):
        return t.astype(jnp.float32).reshape(t.shape[0], t.shape[1], H, d).transpose(0, 2, 1, 3)

    def gates(t):
        z = (t.astype(jnp.float32) + b_gates.astype(jnp.float32)).reshape(t.shape[0], t.shape[1], N_DIRS, 2, H)
        z = z.transpose(2, 3, 0, 4, 1)
        return z[:, 0], jax.nn.log_sigmoid(z[:, 1])

    ql, kl, vl = heads(q, MLSTM_QK_DIM) * scale, heads(k, MLSTM_QK_DIM), heads(v, MLSTM_V_DIM)
    li, lf = gates(g)
    kcc, vcc = heads(kc, MLSTM_QK_DIM), heads(vc, MLSTM_V_DIM)
    lic, lfc = gates(gc)
    qcc = None if qc is None else heads(qc, MLSTM_QK_DIM) * scale
    state0 = (jnp.zeros((B, H, MLSTM_QK_DIM, MLSTM_V_DIM), jnp.float32),
              jnp.zeros((B, H, MLSTM_QK_DIM), jnp.float32),
              jnp.zeros((B, H), jnp.float32))
    lat_out, ctx_out = [], []
    for d in range(N_DIRS):
        rev = d == 1
        c_starts, c_final = mlstm_chunk_states(_maybe_flip(kcc, rev), _maybe_flip(vcc, rev),
                                               _maybe_flip(lic[d], rev), _maybe_flip(lfc[d], rev), state0)
        l_starts, _ = mlstm_chunk_states(_maybe_flip(kl, rev), _maybe_flip(vl, rev),
                                         _maybe_flip(li[d], rev), _maybe_flip(lf[d], rev), c_final)
        lat_out.append(_maybe_flip(mlstm_chunk_outputs(
            _maybe_flip(ql, rev), _maybe_flip(kl, rev), _maybe_flip(vl, rev),
            _maybe_flip(li[d], rev), _maybe_flip(lf[d], rev), l_starts), rev))
        if qcc is not None:
            ctx_out.append(_maybe_flip(mlstm_chunk_outputs(
                _maybe_flip(qcc, rev), _maybe_flip(kcc, rev), _maybe_flip(vcc, rev),
                _maybe_flip(lic[d], rev), _maybe_flip(lfc[d], rev), c_starts), rev))
    h_lat = lat_out[0] + lat_out[1]
    h_ctx = (ctx_out[0] + ctx_out[1]) if qcc is not None else None
    return h_lat, h_ctx


def head_norm(h, g):
    h = h * lax.rsqrt(jnp.mean(h * h, axis=-1, keepdims=True) + NORM_EPS)
    B, H, T, dv = h.shape
    return h.transpose(0, 2, 1, 3).reshape(B, T, H * dv) * g.astype(jnp.float32)


def merge_branches(att, mem, g_att, g_mem, w_attn_proj, w_mlstm_proj, w_out):
    y = jax.nn.sigmoid(g_att) * (att @ w_attn_proj) + jax.nn.sigmoid(g_mem) * (mem @ w_mlstm_proj)
    return y @ w_out


def swiglu(h, w_ffn_in, w_ffn_out):
    gt, up = jnp.split(h @ w_ffn_in, 2, axis=-1)
    return (jax.nn.silu(gt) * up) @ w_ffn_out


def trunk_layer(x, xc, mod, mod_c, rows, cols, norm1_g, w_in, b_gates, attn_sink, mlstm_norm_g,
                w_attn_proj, w_mlstm_proj, w_out, norm2_g, w_ffn_in, w_ffn_out, ctx_out):
    B, S, _ = x.shape
    C = xc.shape[1]
    shift1, scale1, gate1, shift2, scale2, gate2 = mod
    h = modulate(rms_norm(x, norm1_g), shift1, scale1)
    hc = modulate(rms_norm(xc, norm1_g), mod_c[0], mod_c[1])
    p = h @ w_in
    pc = hc @ (w_in if ctx_out else w_in[:, :N_KV_SIDE])
    a_k, a_v, m_k, m_v, m_g = _split(p[..., :N_KV_SIDE], KV_SIDE_SIZES)
    a_q, m_q, m_o, g_att, g_mem = _split(p[..., N_KV_SIDE:], Q_SIDE_SIZES)
    ac_k, ac_v, mc_k, mc_v, mc_g = _split(pc[..., :N_KV_SIDE], KV_SIDE_SIZES)
    mc_q = None
    if ctx_out:
        ac_q, mc_q, mc_o, gc_att, gc_mem = _split(pc[..., N_KV_SIDE:], Q_SIDE_SIZES)

    q = rope_2d(a_q.reshape(B, S, ATTN_HEADS, HEAD_DIM), rows, cols)
    k = rope_2d(a_k.reshape(B, S, ATTN_KV_HEADS, HEAD_DIM), rows, cols)
    v = a_v.reshape(B, S, ATTN_KV_HEADS, HEAD_DIM)
    kc = ac_k.reshape(B, C, ATTN_KV_HEADS, HEAD_DIM)
    vc = ac_v.reshape(B, C, ATTN_KV_HEADS, HEAD_DIM)
    att = window_attention(q, k, v, kc, vc, attn_sink)

    h_mem, hc_mem = mlstm_mixer(m_q, m_k, m_v, m_g, mc_k, mc_v, mc_g, mc_q, b_gates)
    mem = (jax.nn.sigmoid(m_o.astype(jnp.float32)) * head_norm(h_mem, mlstm_norm_g)).astype(x.dtype)

    x = x + gate1 * merge_branches(att, mem, g_att, g_mem, w_attn_proj, w_mlstm_proj, w_out)
    x = x + gate2 * swiglu(modulate(rms_norm(x, norm2_g), shift2, scale2), w_ffn_in, w_ffn_out)

    if ctx_out:
        att_c = context_attention(ac_q.reshape(B, C, ATTN_HEADS, HEAD_DIM), kc, vc, attn_sink)
        mem_c = (jax.nn.sigmoid(mc_o.astype(jnp.float32)) * head_norm(hc_mem, mlstm_norm_g)).astype(xc.dtype)
        xc = xc + mod_c[2] * merge_branches(att_c, mem_c, gc_att, gc_mem, w_attn_proj, w_mlstm_proj, w_out)
        xc = xc + mod_c[5] * swiglu(modulate(rms_norm(xc, norm2_g), mod_c[3], mod_c[4]), w_ffn_in, w_ffn_out)
    return x, xc


def setup_inputs(seed: int = 0) -> dict:
    key = jax.random.key(seed)
    ks = jax.random.split(key, 20)
    nrm = jax.random.normal
    D = D_MODEL
    f_base = jnp.stack([jnp.zeros((MLSTM_HEADS,), jnp.float32),
                        jnp.linspace(FGATE_BIAS_LO, FGATE_BIAS_HI, MLSTM_HEADS, dtype=jnp.float32)])
    b_gates = (f_base[None, None] + 0.1 * nrm(ks[8], (DEPTH, N_DIRS, 2, MLSTM_HEADS), jnp.float32)
               ).reshape(DEPTH, N_GATE)
    return {
        "x": nrm(ks[0], (BATCH, SEQ, D), jnp.float32),
        "c": nrm(ks[1], (BATCH, D), jnp.float32),
        "ctx": nrm(ks[2], (BATCH, CTX_LEN, D), jnp.float32),
        "c_ctx": nrm(ks[3], (D,), jnp.float32),
        "w_ada": nrm(ks[4], (DEPTH, D, N_MOD * D), jnp.float32) * D ** -0.5,
        "b_ada": 0.01 * nrm(ks[5], (DEPTH, N_MOD * D), jnp.float32),
        "norm1_g": 1.0 + 0.01 * nrm(ks[6], (DEPTH, D), jnp.float32),
        "w_in": nrm(ks[7], (DEPTH, D, N_IN), jnp.float32) * D ** -0.5,
        "b_gates": b_gates,
        "attn_sink": 0.5 * nrm(ks[9], (DEPTH, ATTN_HEADS), jnp.float32),
        "mlstm_norm_g": 1.0 + 0.01 * nrm(ks[10], (DEPTH, MLSTM_V_W), jnp.float32),
        "w_attn_proj": nrm(ks[11], (DEPTH, ATTN_Q_W, D), jnp.float32) * ATTN_Q_W ** -0.5,
        "w_mlstm_proj": nrm(ks[12], (DEPTH, MLSTM_V_W, D), jnp.float32) * MLSTM_V_W ** -0.5,
        "w_out": nrm(ks[13], (DEPTH, D, D), jnp.float32) * D ** -0.5,
        "norm2_g": 1.0 + 0.01 * nrm(ks[14], (DEPTH, D), jnp.float32),
        "w_ffn_in": nrm(ks[15], (DEPTH, D, 2 * D_FF), jnp.float32) * D ** -0.5,
        "w_ffn_out": nrm(ks[16], (DEPTH, D_FF, D), jnp.float32) * D_FF ** -0.5,
        "final_norm_g": 1.0 + 0.01 * nrm(ks[17], (D,), jnp.float32),
    }


def reference(x, c, ctx, c_ctx, w_ada, b_ada, norm1_g, w_in, b_gates, attn_sink, mlstm_norm_g,
              w_attn_proj, w_mlstm_proj, w_out, norm2_g, w_ffn_in, w_ffn_out, final_norm_g):
    S = x.shape[1]
    rows_n = S // GRID_W
    rows, cols = jnp.meshgrid(jnp.arange(rows_n), jnp.arange(GRID_W), indexing="ij")
    rows = rows.reshape(-1)
    cols = cols.reshape(-1)
    xc = ctx
    for l in range(DEPTH):
        ctx_out = l < DEPTH - 1
        mod = adaln_params(c[:, None, :], w_ada[l], b_ada[l], N_MOD)
        mod_c = adaln_params(c_ctx, w_ada[l], b_ada[l], N_MOD if ctx_out else 2)
        x, xc = trunk_layer(x, xc, mod, mod_c, rows, cols, norm1_g[l], w_in[l], b_gates[l], attn_sink[l],
                            mlstm_norm_g[l], w_attn_proj[l], w_mlstm_proj[l], w_out[l], norm2_g[l],
                            w_ffn_in[l], w_ffn_out[l], ctx_out)
    return rms_norm(x, final_norm_g)
```

```cpp
#include <hip/hip_runtime.h>
#include <cstdio>
#include <cstdint>

#ifndef MK_N_LAUNCHES
#define MK_N_LAUNCHES 1
#endif

namespace pg8 {
#define PG8_LAS __attribute__((address_space(3)))
typedef unsigned short bf16_t;
typedef short bf16x8 __attribute__((ext_vector_type(8)));
typedef float f32x4 __attribute__((ext_vector_type(4)));
typedef unsigned u32x4 __attribute__((ext_vector_type(4)));
constexpr int BM = 256, BK = 64, HALF = 128, HTB = HALF * BK * 2  , STAGE_BYTES = 8 * HTB, NXCD = 8, WGM = 8;

__host__ __device__ __forceinline__ int lds_byte(int r, int c) { const int st = (r >> 4) * 2 + (c >> 5), rr = r & 15, cc = c & 31, ob = rr * 64 + cc * 2; return st * 1024 + (ob ^ (((ob >> 9) & 1) << 5)); }
__host__ __device__ __forceinline__ void stage_rc(int b, int& R, int& C) { const int st = b / 1024, sb = b % 1024, swz = sb ^ (((sb >> 9) & 1) << 5); R = (st >> 1) * 16 + swz / 64; C = (st & 1) * 32 + (swz % 64) / 2; }
__host__ __device__ __forceinline__ int perm32(int rho) { const int n = rho >> 4, i = rho & 15; return 8 * (i >> 2) + 4 * n + (i & 3); }

struct Unit { int pm, pn, ka, kb, flag; };
struct Gemm { const bf16_t* A; const bf16_t* Bt; int lda, ldb, K; };

__device__ __forceinline__ void tile_map(int L, int nM, int nN, int& pm, int& pn) {
    const int nwg = nM * nN; int wgid = L; { const int q = nwg / NXCD, r = nwg % NXCD, xcd = wgid % NXCD, off = wgid / NXCD; wgid = (xcd < r ? xcd * (q + 1) : r * (q + 1) + (xcd - r) * q) + off; }
    const int nig = WGM * nN, gid = wgid / nig, fm = gid * WGM, gsz = (nM % WGM == 0) ? WGM : ((nM - fm) < WGM ? (nM - fm) : WGM);
    pm = fm + ((wgid % nig) % gsz); pn = (wgid % nig) / gsz;
}
struct OrderPlain {
    int nM, nN, G, c;
    __device__ __forceinline__ bool next(int i, Unit& u) const { const long L = (long)i * G + c; if (L >= (long)nM * nN) return false; tile_map((int)L, nM, nN, u.pm, u.pn); u.ka = 0; u.kb = 0; u.flag = 0; return true; }
    __device__ __forceinline__ void a_ready(const Unit&) const {}
    __device__ __forceinline__ void done(const Unit&) const {}
};
struct OrderPair {
    int nM, nN, G, c, khalf_bytes;
    __device__ __forceinline__ bool next(int i, Unit& u) const { const long L = (long)(i >> 1) * G + c; if (L >= (long)nM * nN) return false; tile_map((int)L, nM, nN, u.pm, u.pn); u.flag = i & 1; u.ka = u.kb = (i & 1) * khalf_bytes; return true; }
    __device__ __forceinline__ void a_ready(const Unit&) const {}
    __device__ __forceinline__ void done(const Unit&) const {}
};
struct OrderInProj {
    int G, c;
    __device__ __forceinline__ bool next(int i, Unit& u) const {
        const long L = (long)i * G + c; u.ka = 0; u.kb = 0; u.flag = 0;
        if (L < 128 * 53) { tile_map((int)L, 128, 53, u.pm, u.pn); return true; }
        const int r = (int)(L - 128 * 53); if (r >= 4 * 17) return false;
        u.pm = 128 + r / 17; const int j = r % 17; u.pn = j < 16 ? j : 52; return true;
    }
    __device__ __forceinline__ void a_ready(const Unit&) const {}
    __device__ __forceinline__ void done(const Unit&) const {}
};

__device__ __forceinline__ unsigned cvt_pk_bf16(float lo, float hi) { unsigned r; asm volatile("v_cvt_pk_bf16_f32 %0, %1, %2" : "=v"(r) : "v"(lo), "v"(hi)); return r; }

template <class Epi, class Sched, bool ALIGN_EPI = false, bool SP2 = false, bool ATILED = false>
__device__ __forceinline__ void gemm_phase(PG8_LAS unsigned char* lds, const Gemm g, const Sched& S, const Epi& E) {
    const int tid = threadIdx.x, wid = __builtin_amdgcn_readfirstlane(tid >> 6), lane = tid & 63, wr = wid >> 2, wc = wid & 3, fr = lane & 15, fq = lane >> 4;
    const int K = g.K, nt = K / BK;
    unsigned voffA[2], voffB[2];
#pragma unroll
    for (int i = 0; i < 2; ++i) { int R, C; stage_rc(tid * 16 + i * 8192, R, C); const int Rb = Epi::PERM ? ((R & ~31) + perm32(R & 31)) : R;
        voffA[i] = ATILED ? (unsigned)(R * BK + C) * 2u : (unsigned)(R * g.lda + C) * 2u; voffB[i] = (unsigned)(tid * 16 + i * 8192); (void)Rb; }
    const size_t kstep = ATILED ? (size_t)BM * BK * 2 : (size_t)(BK * 2);
    const size_t kstepB = (size_t)BM * BK * 2;
    const size_t hstepA = ATILED ? (size_t)HALF * BK * 2 : (size_t)HALF * g.lda * 2, hstepB = (size_t)HALF * BK * 2;
    const size_t tstepA = (size_t)BM * g.lda * 2, tstepB = (size_t)BM * g.ldb * 2;
    const unsigned ldsw = (unsigned)wid * 1024u;
    const int aoff = lds_byte(wr * 64 + fr, fq * 8), boff = lds_byte(wc * 32 + fr, fq * 8);
#define PG8_SA(b, h) (((b) * 2 + (h)) * HTB)
#define PG8_SB(b, h) ((4 + (b) * 2 + (h)) * HTB)
#define PG8_STAGE(bufoff, gbase, voff) do { _Pragma("unroll") for (int _i = 0; _i < 2; ++_i) \
        __builtin_amdgcn_global_load_lds((const unsigned*)((const char*)(gbase) + (voff)[_i]), (PG8_LAS unsigned*)(lds + (bufoff) + ldsw + _i * 8192), 16, 0, 0); } while (0)
#define PG8_LDA(dst, b, h) do { _Pragma("unroll") for (int m = 0; m < 4; ++m) _Pragma("unroll") for (int k = 0; k < 2; ++k) dst[m][k] = *(const PG8_LAS bf16x8*)(lds + PG8_SA(b, h) + aoff + m * 2048 + k * 1024); } while (0)
#define PG8_LDB(dst, b, h) do { _Pragma("unroll") for (int n = 0; n < 2; ++n) _Pragma("unroll") for (int k = 0; k < 2; ++k) dst[n][k] = *(const PG8_LAS bf16x8*)(lds + PG8_SB(b, h) + boff + n * 2048 + k * 1024); } while (0)
#define PG8_MMA(ai, bj, At, Bt) do { __builtin_amdgcn_s_setprio(1); _Pragma("unroll") for (int m = 0; m < 4; ++m) _Pragma("unroll") for (int n = 0; n < 2; ++n) { _Pragma("unroll") for (int k = 0; k < 2; ++k) \
        acc[ai][bj][m][n] = __builtin_amdgcn_mfma_f32_16x16x32_bf16(Bt[n][k], At[m][k], acc[ai][bj][m][n], 0, 0, 0); __builtin_amdgcn_sched_barrier(0); } __builtin_amdgcn_s_setprio(0); } while (0)
#define PG8_WAIT_V(n) asm volatile("s_waitcnt vmcnt(" #n ")" ::: "memory")
#define PG8_WAIT_L(n) asm volatile("s_waitcnt lgkmcnt(" #n ")" ::: "memory")
#define PG8_BAR __builtin_amdgcn_s_barrier()
#define PG8_SCHED __builtin_amdgcn_sched_barrier(0)
    Unit cur, nxt; int ui = 0;
    if (!S.next(0, cur)) return;
    f32x4 acc[2][2][4][2];
#pragma unroll
    for (int a = 0; a < 2; ++a)
#pragma unroll
        for (int b = 0; b < 2; ++b)
#pragma unroll
            for (int m = 0; m < 4; ++m)
#pragma unroll
                for (int n = 0; n < 2; ++n) acc[a][b][m][n] = (f32x4){0.f, 0.f, 0.f, 0.f};
    bf16x8 At[4][2], B0[2][2], B1[2][2];
    const char* cA = (const char*)g.A + (size_t)cur.pm * tstepA + cur.ka; const char* cB = (const char*)g.Bt + (size_t)cur.pn * tstepB + (size_t)(cur.kb >> 7) * kstepB;
    S.a_ready(cur);
    if constexpr (SP2) {
        PG8_STAGE(PG8_SB(0, 0), cB, voffB); PG8_STAGE(PG8_SB(0, 1), cB + hstepB, voffB); PG8_STAGE(PG8_SA(0, 0), cA, voffA); PG8_STAGE(PG8_SA(0, 1), cA + hstepA, voffA);
        if (wr == 1) PG8_BAR;
        PG8_WAIT_V(2); PG8_BAR;
        PG8_STAGE(PG8_SB(1, 0), cB + kstepB, voffB); PG8_STAGE(PG8_SA(1, 0), cA + kstep, voffA); PG8_STAGE(PG8_SB(1, 1), cB + hstepB + kstepB, voffB);
        PG8_WAIT_V(6); PG8_BAR;
    } else {
        PG8_STAGE(PG8_SB(0, 0), cB, voffB); PG8_STAGE(PG8_SA(0, 0), cA, voffA); PG8_STAGE(PG8_SB(0, 1), cB + hstepB, voffB); PG8_STAGE(PG8_SA(0, 1), cA + hstepA, voffA);
        if (wr == 1) PG8_BAR;
        PG8_WAIT_V(4); PG8_BAR;
        PG8_STAGE(PG8_SB(1, 0), cB + kstepB, voffB); PG8_STAGE(PG8_SA(1, 0), cA + kstep, voffA); PG8_STAGE(PG8_SB(1, 1), cB + hstepB + kstepB, voffB);
        PG8_WAIT_V(6); PG8_BAR;
    }
    for (;;) {
        const bool has_next = S.next(ui + 1, nxt);
        const char* nA = has_next ? (const char*)g.A + (size_t)nxt.pm * tstepA + nxt.ka : cA; const char* nB = has_next ? (const char*)g.Bt + (size_t)nxt.pn * tstepB + (size_t)(nxt.kb >> 7) * kstepB : cB;
        for (int t = 0; t < nt; t += 2) {
            const bool last = (t == nt - 2);
            const char* a1 = cA + (size_t)(t + 1) * kstep;
            const char* a2 = last ? nA : cA + (size_t)(t + 2) * kstep; const char* b2 = last ? nB : cB + (size_t)(t + 2) * kstepB;
            const char* a3 = a2 + kstep; const char* b3 = b2 + kstepB;
            if (last && has_next) S.a_ready(nxt);
            if constexpr (SP2) {
            PG8_LDB(B0, 0, 0); PG8_LDB(B1, 0, 1); PG8_SCHED; PG8_LDA(At, 0, 0); PG8_STAGE(PG8_SA(1, 1), a1 + hstepA, voffA);
            PG8_WAIT_V(8); PG8_WAIT_L(0); PG8_BAR; PG8_MMA(0, 0, At, B0); PG8_MMA(0, 1, At, B1); PG8_BAR; PG8_SCHED;
            PG8_LDA(At, 0, 1); PG8_STAGE(PG8_SB(0, 0), b2, voffB); PG8_STAGE(PG8_SB(0, 1), b2 + hstepB, voffB); PG8_STAGE(PG8_SA(0, 0), a2, voffA);
            PG8_WAIT_V(8); PG8_WAIT_L(0); PG8_BAR; PG8_MMA(1, 0, At, B0); PG8_MMA(1, 1, At, B1); PG8_BAR; PG8_SCHED;
            PG8_LDB(B0, 1, 0); PG8_LDB(B1, 1, 1); PG8_SCHED; PG8_LDA(At, 1, 0); PG8_STAGE(PG8_SA(0, 1), a2 + hstepA, voffA);
            PG8_WAIT_V(8); PG8_WAIT_L(0); PG8_BAR; PG8_MMA(0, 0, At, B0); PG8_MMA(0, 1, At, B1); PG8_BAR; PG8_SCHED;
            PG8_LDA(At, 1, 1); PG8_STAGE(PG8_SB(1, 0), b3, voffB); PG8_STAGE(PG8_SB(1, 1), b3 + hstepB, voffB); PG8_STAGE(PG8_SA(1, 0), a3, voffA);
            PG8_WAIT_V(8); PG8_WAIT_L(0); PG8_BAR; PG8_MMA(1, 0, At, B0); PG8_MMA(1, 1, At, B1); PG8_BAR; PG8_SCHED;
            } else {
            PG8_LDB(B0, 0, 0); PG8_SCHED; PG8_LDA(At, 0, 0); PG8_STAGE(PG8_SA(1, 1), a1 + hstepA, voffA);
            PG8_WAIT_L(8); PG8_BAR; PG8_WAIT_L(0); PG8_MMA(0, 0, At, B0); PG8_BAR; PG8_SCHED;
            PG8_LDB(B1, 0, 1); PG8_STAGE(PG8_SB(0, 0), b2, voffB);
            PG8_BAR; PG8_WAIT_L(0); PG8_MMA(0, 1, At, B1); PG8_BAR;
            PG8_LDA(At, 0, 1); PG8_STAGE(PG8_SA(0, 0), a2, voffA);
            PG8_BAR; PG8_WAIT_L(0); PG8_MMA(1, 0, At, B0); PG8_BAR; PG8_SCHED;
            PG8_STAGE(PG8_SB(0, 1), b2 + hstepB, voffB);
            PG8_WAIT_V(6); PG8_BAR; PG8_MMA(1, 1, At, B1); PG8_BAR;
            PG8_LDB(B0, 1, 0); PG8_SCHED; PG8_LDA(At, 1, 0); PG8_STAGE(PG8_SA(0, 1), a2 + hstepA, voffA);
            PG8_WAIT_L(8); PG8_BAR; PG8_WAIT_L(0); PG8_MMA(0, 0, At, B0); PG8_BAR; PG8_SCHED;
            PG8_LDB(B1, 1, 1); PG8_STAGE(PG8_SB(1, 0), b3, voffB);
            PG8_BAR; PG8_WAIT_L(0); PG8_MMA(0, 1, At, B1); PG8_BAR;
            PG8_LDA(At, 1, 1); PG8_STAGE(PG8_SA(1, 0), a3, voffA);
            PG8_BAR; PG8_WAIT_L(0); PG8_MMA(1, 0, At, B0); PG8_BAR; PG8_SCHED;
            PG8_STAGE(PG8_SB(1, 1), b3 + hstepB, voffB);
            PG8_WAIT_V(6); PG8_BAR; PG8_MMA(1, 1, At, B1); PG8_BAR;
            }
        }
        if constexpr (ALIGN_EPI) { if (wr == 0) PG8_BAR; }
        E(acc, cur, wr, wc, fr, fq); S.done(cur);
        if (!has_next) break;
        if (!E.keep(cur)) {
#pragma unroll
        for (int a = 0; a < 2; ++a)
#pragma unroll
            for (int b = 0; b < 2; ++b)
#pragma unroll
                for (int m = 0; m < 4; ++m)
#pragma unroll
                    for (int n = 0; n < 2; ++n) acc[a][b][m][n] = (f32x4){0.f, 0.f, 0.f, 0.f};
        }
        cur = nxt; cA = nA; cB = nB; ++ui;
        if constexpr (ALIGN_EPI) { if (wr == 1) PG8_BAR; }
    }
    PG8_WAIT_V(0);
    if constexpr (!ALIGN_EPI) { if (wr == 0) PG8_BAR; }
    PG8_BAR;
#undef PG8_SA
#undef PG8_SB
#undef PG8_STAGE
#undef PG8_LDA
#undef PG8_LDB
#undef PG8_MMA
#undef PG8_WAIT_V
#undef PG8_WAIT_L
#undef PG8_BAR
#undef PG8_SCHED
}
}

#ifndef PG8_SP2
#define PG8_SP2 true
#endif
#ifndef PG8_ALIGN
#define PG8_ALIGN true
#endif

constexpr int NWAVES = 8;
constexpr int N_LAUNCHES = MK_N_LAUNCHES;
constexpr int N_PHASES = 13;
constexpr int D = 2048, NB = 4, SEQ = 8192, CL = 256, MLAT = NB * SEQ, MCTX = NB * CL, MTOT = MLAT + MCTX;
constexpr int DFF = 5632, NMOD = 6 * D;
constexpr int W_IN_COLS = 13344;
constexpr int NIN_T = 53 * 256;
constexpr float NORM_EPS = 1e-6f;
constexpr float QSCALE = 0.08838834764831845f;

constexpr size_t MiB = 1u << 20;
constexpr size_t WS_CTL = 0, CTL_ZERO_BYTES = 1 * MiB;
constexpr size_t WS_MOD = 1 * MiB;
constexpr size_t WS_ROPE = 1 * MiB + 512 * 1024;
constexpr size_t WS_MODP = 2 * MiB;
constexpr size_t WS_GU = 2 * MiB, WS_GB = 5 * MiB, WS_GS = 8 * MiB;
constexpr size_t WS_GATES = 10 * MiB;
constexpr size_t WS_CKA = 16 * MiB, WS_CVA = 17 * MiB, WS_CMK = 18 * MiB, WS_CMV = 20 * MiB;
constexpr size_t WS_WAM = 24 * MiB;
constexpr size_t WS_WOUT = 40 * MiB;
constexpr size_t WS_WFFI = 48 * MiB;
constexpr size_t WS_WFFO = 92 * MiB;
constexpr size_t WS_WIN = 114 * MiB;
constexpr size_t WS_H = 168 * MiB;
constexpr size_t WS_AM = 300 * MiB;
constexpr size_t WS_KA = 556 * MiB, WS_VA = 588 * MiB;
constexpr size_t WS_MQ = 620 * MiB, WS_MK = 684 * MiB;
constexpr size_t WS_MV = 748 * MiB;
constexpr size_t WS_H1 = 876 * MiB;
constexpr size_t WS_Y = 556 * MiB;
constexpr size_t WS_HDN = 300 * MiB;
constexpr size_t WS_END = 1004 * MiB;
constexpr int CW_TMO = 0, CW_CODE = 1, CW_QUEUE = 64, CW_AQUEUE = 96;
constexpr int CW_BAR = 4096;

constexpr int RING_OFF = 0, RING_BYTES = 131072;
constexpr int LDSCTL_OFF = RING_BYTES, MISC_OFF = LDSCTL_OFF + 320;
constexpr int LDS_BYTES = 147456;

#define GAS __attribute__((address_space(1)))
#define LAS __attribute__((address_space(3)))
typedef unsigned short bf16;
typedef unsigned v4u __attribute__((ext_vector_type(4)));
typedef unsigned v2u __attribute__((ext_vector_type(2)));
typedef float f32x4 __attribute__((ext_vector_type(4)));
typedef GAS unsigned gu32;
#define RLX_AGENT __ATOMIC_RELAXED, __HIP_MEMORY_SCOPE_AGENT
#define LDS_WAIT() asm volatile("s_waitcnt lgkmcnt(0)" ::: "memory")
#define VM_WAIT() asm volatile("s_waitcnt vmcnt(0)" ::: "memory")
__device__ __forceinline__ unsigned f2bf(float f) { unsigned u = __builtin_bit_cast(unsigned, f); return (u + 0x7fffu + ((u >> 16) & 1u)) >> 16; }
__device__ __forceinline__ unsigned pk2(float lo, float hi) { return f2bf(lo) | (f2bf(hi) << 16); }
__device__ __forceinline__ float bflo(unsigned w) { return __builtin_bit_cast(float, w << 16); }
__device__ __forceinline__ float bfhi(unsigned w) { return __builtin_bit_cast(float, w & 0xffff0000u); }
__device__ __forceinline__ float bf2f(bf16 h) { return __builtin_bit_cast(float, (unsigned)h << 16); }
__device__ __forceinline__ float wave_sum(float v) {
#pragma unroll
    for (int o = 1; o < 64; o <<= 1) v += __shfl_xor(v, o);
    return v;
}
template <int CTRL, int ROWMASK> __device__ __forceinline__ float dpp_add(float v) { return v + __builtin_bit_cast(float, __builtin_amdgcn_update_dpp(0, __builtin_bit_cast(int, v), CTRL, ROWMASK, 0xf, true)); }
__device__ __forceinline__ float half_sums_dpp(float v) {
    v = dpp_add<0x111, 0xf>(v); v = dpp_add<0x112, 0xf>(v); v = dpp_add<0x114, 0xf>(v); v = dpp_add<0x118, 0xf>(v);
    return v + __builtin_bit_cast(float, __builtin_amdgcn_update_dpp(0, __builtin_bit_cast(int, v), 0x142, 0xa, 0xf, false));
}
__device__ __forceinline__ float wave_sum_dpp(float v) {
    v = half_sums_dpp(v);
    return __builtin_bit_cast(float, __builtin_amdgcn_readlane(__builtin_bit_cast(int, v), 31)) + __builtin_bit_cast(float, __builtin_amdgcn_readlane(__builtin_bit_cast(int, v), 63));
}
__device__ __forceinline__ float wave_max(float v) {
#pragma unroll
    for (int o = 1; o < 64; o <<= 1) v = fmaxf(v, __shfl_xor(v, o));
    return v;
}
__device__ __forceinline__ float frcp(float x) { return __builtin_amdgcn_rcpf(x); }
__device__ __forceinline__ float sigmoidf_(float x) { return frcp(1.0f + __expf(-x)); }

#define XB_TMO      128
#define XB_XCNT(j)  (256  + 64 * (j))
#define XB_XSUB(j)  (1280 + 64 * (j))
#define XB_XGEN(j)  (2304 + 64 * (j))
#define XB_TOP      3328
#define XB_TOPGEN   3392
#define XCD_BAR_WORDS 3456
#define XB_SPIN_CAP (1u << 18)

__device__ __forceinline__ unsigned xb_ld(unsigned* p)              { return __hip_atomic_load(p, __ATOMIC_RELAXED, __HIP_MEMORY_SCOPE_AGENT); }
__device__ __forceinline__ unsigned xb_add(unsigned* p, unsigned v) { return __hip_atomic_fetch_add(p, v, __ATOMIC_RELAXED, __HIP_MEMORY_SCOPE_AGENT); }
__device__ __forceinline__ unsigned xb_xcc_id() { return (unsigned)__builtin_amdgcn_s_getreg((3 << 11) | 20) & 0xFu; }
#define XB_SPIN(cond, bar) do { unsigned _sp = 0; while (cond) { __builtin_amdgcn_s_sleep(1); \
    if ((++_sp & 255u) == 0u) { if (xb_ld(&(bar)[XB_TMO])) break; if (_sp > XB_SPIN_CAP) { atomicAdd(&(bar)[XB_TMO], 1u); break; } } } } while (0)

struct XcdBarrier {
    unsigned* bar; unsigned x;
    volatile LAS unsigned* st;
};
__device__ __forceinline__ XcdBarrier xcd_barrier_post(unsigned* bar, volatile LAS unsigned* st) {
    XcdBarrier b; b.bar = bar; b.x = xb_xcc_id(); b.st = st;
    if (threadIdx.x == 0) (void)xb_add(&bar[XB_XCNT(b.x)], 1u);
    return b;
}
__device__ __forceinline__ void xcd_barrier_complete(unsigned* bar, unsigned x, unsigned& nloc, unsigned& nx) {
    const unsigned G = gridDim.x * gridDim.y * gridDim.z;
    unsigned sum, cnt, mine, sp = 0u;
    for (;;) {
        sum = 0u; cnt = 0u; mine = 0u;
#pragma unroll
        for (unsigned j = 0; j < 16; ++j) { const unsigned c = xb_ld(&bar[XB_XCNT(j)]); sum += c; cnt += (c > 0u) ? 1u : 0u; mine = (j == x) ? c : mine; }
        if (sum == G) break;
        __builtin_amdgcn_s_sleep(1);
        if ((++sp & 255u) == 0u) { if (xb_ld(&bar[XB_TMO])) break; if (sp > XB_SPIN_CAP) { atomicAdd(&bar[XB_TMO], 1u); break; } }
    }
    nloc = mine > 0u ? mine : 1u; nx = cnt > 0u ? cnt : 1u;
}
__device__ __forceinline__ void xcd_barrier(const XcdBarrier& b) {
    asm volatile("s_waitcnt vmcnt(0)" ::: "memory");
    __syncthreads();
    if (threadIdx.x == 0) {
        unsigned* bar = b.bar;
        __builtin_amdgcn_s_waitcnt(0);
        unsigned nloc = b.st[0], nx = b.st[1];
        if (nloc == 0u) { xcd_barrier_complete(bar, b.x, nloc, nx); b.st[0] = nloc; b.st[1] = nx; }
        const unsigned old = xb_add(&bar[XB_XSUB(b.x)], 1u);
        const unsigned gen = old / nloc;
        if (old + 1u == (gen + 1u) * nloc) {
            __builtin_amdgcn_fence(__ATOMIC_RELEASE, "agent");
            asm volatile("s_waitcnt vmcnt(0)" ::: "memory");
            const unsigned og = xb_add(&bar[XB_TOP], 1u);
            const unsigned tg = og / nx;
            if (og + 1u == (tg + 1u) * nx) xb_add(&bar[XB_TOPGEN], 1u);
            else XB_SPIN(xb_ld(&bar[XB_TOPGEN]) == tg, bar);
            __builtin_amdgcn_fence(__ATOMIC_ACQUIRE, "agent");
            xb_add(&bar[XB_XGEN(b.x)], 1u);
            asm volatile("s_waitcnt vmcnt(0)" ::: "memory");
        } else {
            XB_SPIN(xb_ld(&bar[XB_XGEN(b.x)]) == gen, bar);
            __builtin_amdgcn_fence(__ATOMIC_ACQUIRE, "agent");
            asm volatile("s_waitcnt vmcnt(0)" ::: "memory");
        }
    }
    __syncthreads();
}

struct Frame {
    LAS unsigned char* lds;
    volatile LAS unsigned* MISC;
    gu32* ctl;
    int wave, G, bid;
    const float *x, *c, *ctx, *c_ctx, *w_ada, *b_ada, *norm1_g, *w_in, *b_gates, *attn_sink, *mlstm_norm_g, *w_attn_proj, *w_mlstm_proj, *w_out, *norm2_g, *w_ffn_in, *w_ffn_out, *final_norm_g;
    float* out;
    float *MOD, *ROPE, *MODP, *GATES, *GU, *GB, *GS;
    bf16 *CKA, *CVA, *CMK, *CMV, *WAM, *WOUT, *WFFI, *WFFO, *WIN, *H, *AM, *KA, *VA, *MQ, *MK, *MV, *H0, *H1, *Y, *HDN, *GG;
};

__device__ __forceinline__ pg8::u32x4 lane_t(pg8::u32x4 w, int srcb) { pg8::u32x4 r; r.x = (unsigned)__builtin_amdgcn_ds_bpermute(srcb, (int)w.x); r.y = (unsigned)__builtin_amdgcn_ds_bpermute(srcb, (int)w.y); r.z = (unsigned)__builtin_amdgcn_ds_bpermute(srcb, (int)w.z); r.w = (unsigned)__builtin_amdgcn_ds_bpermute(srcb, (int)w.w); return r; }
#define LANE_T_SETUP const int lt_l = fr + 16 * fq, rr = lt_l >> 2, cq = lt_l & 3, srcb = 4 * (rr + 16 * cq);
struct EpiInProj {
    static constexpr bool PERM = true;
    bf16 *AM, *KA, *VA, *MQ, *MK, *MV, *GG, *CKA, *CVA, *CMK, *CMV; float* GATES; const float* ROPE;
    __device__ __forceinline__ bool keep(const pg8::Unit&) const { return false; }
    __device__ __forceinline__ void operator()(pg8::f32x4 (&acc)[2][2][4][2], const pg8::Unit& u, int wr, int wc, int fr, int fq) const {
        const int pn = u.pn; const int row0 = u.pm * 256 + wr * 64 + fr; LANE_T_SETUP
        if (pn == 52) {
            if (wc == 0) {
#pragma unroll
                for (int ai = 0; ai < 2; ++ai)
#pragma unroll
                    for (int m = 0; m < 4; ++m) { float* gp = GATES + (size_t)(row0 + ai * 128 + m * 16) * 32 + 8 * fq; *(pg8::f32x4*)gp = acc[ai][0][m][0]; *(pg8::f32x4*)(gp + 4) = acc[ai][0][m][1]; }
            }
            return;
        }
        bf16* base; int ldc, coff; int rsub = 0;
        if (u.pm < 128) {
            if (pn < 2)       { base = KA; ldc = 512;  coff = pn * 256; }
            else if (pn < 4)  { base = VA; ldc = 512;  coff = (pn - 2) * 256; }
            else if (pn < 8)  { base = MK; ldc = 1024; coff = (pn - 4) * 256; }
            else if (pn < 16) { base = MV; ldc = 2048; coff = (pn - 8) * 256; }
            else if (pn < 24) { base = AM; ldc = 4096; coff = (pn - 16) * 256; }
            else if (pn < 28) { base = MQ; ldc = 1024; coff = (pn - 24) * 256; }
            else if (pn < 36) { base = AM; ldc = 4096; coff = 2048 + (pn - 28) * 256; }
            else              { base = GG; ldc = 4096; coff = (pn - 36) * 256; }
        } else {
            rsub = MLAT;
            if (pn < 2)       { base = CKA; ldc = 512;  coff = pn * 256; }
            else if (pn < 4)  { base = CVA; ldc = 512;  coff = (pn - 2) * 256; }
            else if (pn < 8)  { base = CMK; ldc = 1024; coff = (pn - 4) * 256; }
            else              { base = CMV; ldc = 2048; coff = (pn - 8) * 256; }
        }
        if (pn < 2 || (pn >= 16 && pn < 24)) {
            const int half = wc >> 1, i0 = 16 * (wc & 1) + 4 * fq; const bool rot = u.pm < 128;
            pg8::f32x4 csr[2][4], snr[2][4];
#pragma unroll
            for (int ai = 0; ai < 2; ++ai)
#pragma unroll
                for (int m = 0; m < 4; ++m) { const int row = row0 - rsub + ai * 128 + m * 16; const int t = row & (SEQ - 1); const int pos = half ? (t & 63) : (t >> 6);
                    csr[ai][m] = (pg8::f32x4){1.f, 1.f, 1.f, 1.f}; snr[ai][m] = (pg8::f32x4){0.f, 0.f, 0.f, 0.f};
                    if (rot) { csr[ai][m] = *(const pg8::f32x4*)(ROPE + pos * 32 + i0); snr[ai][m] = *(const pg8::f32x4*)(ROPE + 4096 + pos * 32 + i0); } }
#pragma unroll
            for (int ai = 0; ai < 2; ++ai)
#pragma unroll
                for (int m = 0; m < 4; ++m) { const int row = row0 - rsub + ai * 128 + m * 16; const pg8::f32x4 cs = csr[ai][m], sn = snr[ai][m];
                    bf16* rowp = base + (size_t)(row - fr + rr) * ldc + coff + wc * 32 + 8 * cq;
                    pg8::u32x4 w[2];
#pragma unroll
                    for (int bj = 0; bj < 2; ++bj) { const pg8::f32x4 x1 = acc[ai][bj][m][0], x2 = acc[ai][bj][m][1]; const pg8::f32x4 o1 = x1 * cs - x2 * sn, o2 = x2 * cs + x1 * sn;
                        w[bj].x = pg8::cvt_pk_bf16(o1[0], o1[1]); w[bj].y = pg8::cvt_pk_bf16(o1[2], o1[3]); w[bj].z = pg8::cvt_pk_bf16(o2[0], o2[1]); w[bj].w = pg8::cvt_pk_bf16(o2[2], o2[3]); }
                    const pg8::u32x4 t0 = lane_t(w[0], srcb), t1 = lane_t(w[1], srcb);
                    *(pg8::u32x4*)rowp = t0; *(pg8::u32x4*)(rowp + 128) = t1; }
            return;
        }
        const int col0 = coff + wc * 32 + 8 * cq; bf16* const rowp0 = base + (size_t)(row0 - fr + rr - rsub) * ldc + col0;
#pragma unroll
        for (int ai = 0; ai < 2; ++ai)
#pragma unroll
            for (int m = 0; m < 4; ++m) { bf16* rowp = rowp0 + (size_t)(ai * 128 + m * 16) * (size_t)ldc;
                pg8::u32x4 w[2];
#pragma unroll
                for (int bj = 0; bj < 2; ++bj) { const pg8::f32x4 v0 = acc[ai][bj][m][0], v1 = acc[ai][bj][m][1];
                    w[bj].x = pg8::cvt_pk_bf16(v0[0], v0[1]); w[bj].y = pg8::cvt_pk_bf16(v0[2], v0[3]); w[bj].z = pg8::cvt_pk_bf16(v1[0], v1[1]); w[bj].w = pg8::cvt_pk_bf16(v1[2], v1[3]); }
                const pg8::u32x4 t0 = lane_t(w[0], srcb), t1 = lane_t(w[1], srcb);
                __builtin_nontemporal_store(t0, (pg8::u32x4*)rowp); __builtin_nontemporal_store(t1, (pg8::u32x4*)(rowp + 128)); }
    }
};
struct EpiMerge {
    static constexpr bool PERM = true;
    const bf16* GG; bf16* Y;
    __device__ __forceinline__ bool keep(const pg8::Unit& u) const { return u.flag == 0; }
    __device__ __forceinline__ void operator()(pg8::f32x4 (&acc)[2][2][4][2], const pg8::Unit& u, int wr, int wc, int fr, int fq) const {
        const int row0 = u.pm * 256 + wr * 64 + fr, col0 = u.pn * 256 + wc * 32 + 8 * fq; LANE_T_SETUP
        const bf16* gp = GG + (size_t)row0 * 4096 + col0;
        if (u.flag == 0) {
            pg8::u32x4 gmr[8], gar[8];
#pragma unroll
            for (int m = 0; m < 4; ++m)
#pragma unroll
                for (int bj = 0; bj < 2; ++bj) { const bf16* q = gp + (size_t)(m * 16) * 4096 + bj * 128; gmr[2 * m + bj] = *(const pg8::u32x4*)(q + 2048); gar[2 * m + bj] = *(const pg8::u32x4*)q; }
#pragma unroll
            for (int ai = 0; ai < 2; ++ai)
#pragma unroll
                for (int m = 0; m < 4; ++m)
#pragma unroll
                    for (int bj = 0; bj < 2; ++bj) { const pg8::u32x4 gm = gmr[2 * m + bj], ga = gar[2 * m + bj];
                        if (ai == 0) { const bf16* q = gp + (size_t)(128 + m * 16) * 4096 + bj * 128; gmr[2 * m + bj] = *(const pg8::u32x4*)(q + 2048); gar[2 * m + bj] = *(const pg8::u32x4*)q; }
#pragma unroll
                        for (int j = 0; j < 4; ++j) { const float em0 = __expf(-fminf(fmaxf(bflo(gm[j]), -30.f), 30.f)), em1 = __expf(-fminf(fmaxf(bfhi(gm[j]), -30.f), 30.f));
                            const float ea0 = __expf(-fminf(fmaxf(bflo(ga[j]), -30.f), 30.f)), ea1 = __expf(-fminf(fmaxf(bfhi(ga[j]), -30.f), 30.f));
                            const float r0 = (1.f + em0) * frcp(1.f + ea0), r1 = (1.f + em1) * frcp(1.f + ea1);
                            acc[ai][bj][m][j >> 1][(2 * j) & 3] *= r0; acc[ai][bj][m][j >> 1][(2 * j + 1) & 3] *= r1; } }
        } else {
            pg8::u32x4 gmr[2][8];
#pragma unroll
            for (int ai = 0; ai < 2; ++ai)
#pragma unroll
                for (int m = 0; m < 4; ++m)
#pragma unroll
                    for (int bj = 0; bj < 2; ++bj) gmr[ai][2 * m + bj] = *(const pg8::u32x4*)(gp + (size_t)(ai * 128 + m * 16) * 4096 + bj * 128 + 2048);
            bf16* yp = Y + ((((size_t)u.pm * 32 + u.pn * 4 + (wc >> 1)) * 256 + (wr * 64 + rr)) << 6) + 32 * (wc & 1) + 8 * cq;
#pragma unroll
            for (int ai = 0; ai < 2; ++ai)
#pragma unroll
                for (int m = 0; m < 4; ++m) { pg8::u32x4 w[2];
#pragma unroll
                    for (int bj = 0; bj < 2; ++bj) { const pg8::u32x4 gm = gmr[ai][2 * m + bj]; float v[8];
#pragma unroll
                        for (int j = 0; j < 4; ++j) { const float em0 = __expf(-fminf(fmaxf(bflo(gm[j]), -30.f), 30.f)), em1 = __expf(-fminf(fmaxf(bfhi(gm[j]), -30.f), 30.f));
                            v[2 * j] = acc[ai][bj][m][j >> 1][(2 * j) & 3] * frcp(1.f + em0); v[2 * j + 1] = acc[ai][bj][m][j >> 1][(2 * j + 1) & 3] * frcp(1.f + em1); }
                        w[bj].x = pg8::cvt_pk_bf16(v[0], v[1]); w[bj].y = pg8::cvt_pk_bf16(v[2], v[3]); w[bj].z = pg8::cvt_pk_bf16(v[4], v[5]); w[bj].w = pg8::cvt_pk_bf16(v[6], v[7]); }
                    const pg8::u32x4 t0 = lane_t(w[0], srcb), t1 = lane_t(w[1], srcb);
                    bf16* o = yp + (size_t)(ai * 128 + m * 16) * 64; *(pg8::u32x4*)o = t0; *(pg8::u32x4*)(o + 2 * 256 * 64) = t1; }
        }
    }
};
struct EpiResid {
    static constexpr bool PERM = false;
    const float* base; float* out; const float* gate;
    __device__ __forceinline__ bool keep(const pg8::Unit&) const { return false; }
    __device__ __forceinline__ void operator()(pg8::f32x4 (&acc)[2][2][4][2], const pg8::Unit& u, int wr, int wc, int fr, int fq) const {
        const int row0 = u.pm * 256 + wr * 64 + fr, col0 = u.pn * 256 + wc * 32 + 4 * fq; const float* gp = gate + (size_t)(u.pm >> 5) * NMOD + col0;
        pg8::f32x4 gv[2][2];
#pragma unroll
        for (int bj = 0; bj < 2; ++bj)
#pragma unroll
            for (int n = 0; n < 2; ++n) gv[bj][n] = *(const pg8::f32x4*)(gp + bj * 128 + n * 16);
#pragma unroll
        for (int ai = 0; ai < 2; ++ai)
#pragma unroll
            for (int m = 0; m < 4; ++m) { const size_t off = (size_t)(row0 + ai * 128 + m * 16) * D + col0;
#pragma unroll
                for (int bj = 0; bj < 2; ++bj)
#pragma unroll
                    for (int n = 0; n < 2; ++n) { const pg8::f32x4 bs = *(const pg8::f32x4*)(base + off + bj * 128 + n * 16); *(pg8::f32x4*)(out + off + bj * 128 + n * 16) = bs + gv[bj][n] * acc[ai][bj][m][n]; }
                asm volatile("" ::: "memory"); }
    }
};
struct EpiResidBf16 {
    static constexpr bool PERM = true;
    const float* base; bf16* out; const float* gate;
    __device__ __forceinline__ bool keep(const pg8::Unit&) const { return false; }
    __device__ __forceinline__ void operator()(pg8::f32x4 (&acc)[2][2][4][2], const pg8::Unit& u, int wr, int wc, int fr, int fq) const {
        const int row0 = u.pm * 256 + wr * 64 + fr, col0 = u.pn * 256 + wc * 32 + 8 * fq; const float* gp = gate + (size_t)(u.pm >> 5) * NMOD + col0; LANE_T_SETUP
        const float* bp = base + (size_t)row0 * D + col0;
        pg8::f32x4 br[8][2];
#pragma unroll
        for (int m = 0; m < 4; ++m)
#pragma unroll
            for (int bj = 0; bj < 2; ++bj) { const float* q = bp + (size_t)(m * 16) * D + bj * 128; br[2 * m + bj][0] = *(const pg8::f32x4*)q; br[2 * m + bj][1] = *(const pg8::f32x4*)(q + 4); }
        pg8::f32x4 gv[2][2];
#pragma unroll
        for (int bj = 0; bj < 2; ++bj)
#pragma unroll
            for (int n = 0; n < 2; ++n) gv[bj][n] = *(const pg8::f32x4*)(gp + bj * 128 + n * 4);
        bf16* op = out + (size_t)(row0 - fr + rr) * D + col0 + 8 * (cq - fq);
#pragma unroll
        for (int ai = 0; ai < 2; ++ai)
#pragma unroll
            for (int m = 0; m < 4; ++m) { pg8::u32x4 w[2];
#pragma unroll
                for (int bj = 0; bj < 2; ++bj) { const pg8::f32x4 b0 = br[2 * m + bj][0], b1 = br[2 * m + bj][1];
                    if (ai == 0) { const float* q = bp + (size_t)(128 + m * 16) * D + bj * 128; br[2 * m + bj][0] = *(const pg8::f32x4*)q; br[2 * m + bj][1] = *(const pg8::f32x4*)(q + 4); }
                    const pg8::f32x4 v0 = b0 + gv[bj][0] * acc[ai][bj][m][0], v1 = b1 + gv[bj][1] * acc[ai][bj][m][1];
                    w[bj].x = pg8::cvt_pk_bf16(v0[0], v0[1]); w[bj].y = pg8::cvt_pk_bf16(v0[2], v0[3]); w[bj].z = pg8::cvt_pk_bf16(v1[0], v1[1]); w[bj].w = pg8::cvt_pk_bf16(v1[2], v1[3]); }
                const pg8::u32x4 t0 = lane_t(w[0], srcb), t1 = lane_t(w[1], srcb);
                bf16* o = op + (size_t)(ai * 128 + m * 16) * D; *(pg8::u32x4*)o = t0; *(pg8::u32x4*)(o + 128) = t1; }
    }
};
struct EpiResidBB {
    static constexpr bool PERM = true;
    const bf16* base; bf16* out; const float* gate;
    __device__ __forceinline__ bool keep(const pg8::Unit&) const { return false; }
    __device__ __forceinline__ void operator()(pg8::f32x4 (&acc)[2][2][4][2], const pg8::Unit& u, int wr, int wc, int fr, int fq) const {
        const int row0 = u.pm * 256 + wr * 64 + fr, col0 = u.pn * 256 + wc * 32 + 8 * fq; const float* gp = gate + (size_t)(u.pm >> 5) * NMOD + col0; LANE_T_SETUP
        pg8::u32x4 bw[2][8];
        const bf16* bp = base + (size_t)row0 * D + col0;
#pragma unroll
        for (int ai = 0; ai < 2; ++ai)
#pragma unroll
            for (int m = 0; m < 4; ++m)
#pragma unroll
                for (int bj = 0; bj < 2; ++bj) bw[ai][2 * m + bj] = *(const pg8::u32x4*)(bp + (size_t)(ai * 128 + m * 16) * D + bj * 128);
        pg8::f32x4 gv[2][2];
#pragma unroll
        for (int bj = 0; bj < 2; ++bj)
#pragma unroll
            for (int n = 0; n < 2; ++n) gv[bj][n] = *(const pg8::f32x4*)(gp + bj * 128 + n * 4);
        bf16* op = out + (size_t)(row0 - fr + rr) * D + col0 + 8 * (cq - fq);
#pragma unroll
        for (int ai = 0; ai < 2; ++ai)
#pragma unroll
            for (int m = 0; m < 4; ++m) { pg8::u32x4 w[2];
#pragma unroll
                for (int bj = 0; bj < 2; ++bj) { const pg8::u32x4 b = bw[ai][2 * m + bj];
                    const pg8::f32x4 b0 = (pg8::f32x4){bflo(b.x), bfhi(b.x), bflo(b.y), bfhi(b.y)}, b1 = (pg8::f32x4){bflo(b.z), bfhi(b.z), bflo(b.w), bfhi(b.w)};
                    const pg8::f32x4 v0 = b0 + gv[bj][0] * acc[ai][bj][m][0], v1 = b1 + gv[bj][1] * acc[ai][bj][m][1];
                    w[bj].x = pg8::cvt_pk_bf16(v0[0], v0[1]); w[bj].y = pg8::cvt_pk_bf16(v0[2], v0[3]); w[bj].z = pg8::cvt_pk_bf16(v1[0], v1[1]); w[bj].w = pg8::cvt_pk_bf16(v1[2], v1[3]); }
                const pg8::u32x4 t0 = lane_t(w[0], srcb), t1 = lane_t(w[1], srcb);
                bf16* o = op + (size_t)(ai * 128 + m * 16) * D; *(pg8::u32x4*)o = t0; *(pg8::u32x4*)(o + 128) = t1; }
    }
};
struct EpiSwiGLU {
    static constexpr bool PERM = true;
    bf16* HDN;
    __device__ __forceinline__ bool keep(const pg8::Unit&) const { return false; }
    __device__ __forceinline__ void operator()(pg8::f32x4 (&acc)[2][2][4][2], const pg8::Unit& u, int wr, int wc, int fr, int fq) const {
        LANE_T_SETUP const int row0 = u.pm * 256 + wr * 64 + rr, col0 = u.pn * 128 + wc * 32 + 8 * cq;
#pragma unroll
        for (int ai = 0; ai < 2; ++ai)
#pragma unroll
            for (int m2 = 0; m2 < 4; m2 += 2) { pg8::u32x4 w[2];
#pragma unroll
                for (int mm = 0; mm < 2; ++mm) { const int m = m2 + mm; float v[8];
#pragma unroll
                    for (int j = 0; j < 8; ++j) { const float gt = acc[ai][0][m][j >> 2][j & 3], up = acc[ai][1][m][j >> 2][j & 3]; v[j] = gt * up * frcp(1.f + __expf(-gt)); }
                    w[mm].x = pg8::cvt_pk_bf16(v[0], v[1]); w[mm].y = pg8::cvt_pk_bf16(v[2], v[3]); w[mm].z = pg8::cvt_pk_bf16(v[4], v[5]); w[mm].w = pg8::cvt_pk_bf16(v[6], v[7]); }
                const pg8::u32x4 t0 = lane_t(w[0], srcb), t1 = lane_t(w[1], srcb);
                bf16* hp_ = HDN + ((((size_t)u.pm * 88 + u.pn * 2 + (wc >> 1)) * 256 + (wr * 64 + rr + ai * 128 + m2 * 16)) << 6) + 32 * (wc & 1) + 8 * cq;
                __builtin_nontemporal_store(t0, (pg8::u32x4*)hp_); __builtin_nontemporal_store(t1, (pg8::u32x4*)(hp_ + 16 * 64)); }
    }
};

struct CItem { const float* src; bf16* dst; int src_ld, k0, c0, dst_ld, drow0, dk0, rperm; float scale; };
__device__ __forceinline__ void ci_load(const CItem& c, f32x4 (&t)[8], int lane) {
    const int kr = lane >> 3, c4 = (lane & 7) * 4;
    if (c.src) {
#pragma unroll
        for (int i = 0; i < 8; ++i) t[i] = *(const GAS f32x4*)(c.src + (size_t)(c.k0 + 8 * kr + i) * c.src_ld + c.c0 + c4);
    } else {
#pragma unroll
        for (int i = 0; i < 8; ++i) t[i] = (f32x4){0.f, 0.f, 0.f, 0.f};
    }
}
__device__ __forceinline__ void ci_store(const CItem& c, const f32x4 (&t)[8], int lane) {
    const int kr = lane >> 3, c4 = (lane & 7) * 4; const float scale = c.scale; const int rperm = c.rperm;
#pragma unroll
    for (int j = 0; j < 4; ++j) { const int n = c4 + j;
        v4u o; o.x = pg8::cvt_pk_bf16(t[0][j] * scale, t[1][j] * scale); o.y = pg8::cvt_pk_bf16(t[2][j] * scale, t[3][j] * scale); o.z = pg8::cvt_pk_bf16(t[4][j] * scale, t[5][j] * scale); o.w = pg8::cvt_pk_bf16(t[6][j] * scale, t[7][j] * scale);
        const int drow = rperm < 0 ? (c.drow0 + n) : (c.drow0 + 32 * (2 * (rperm >> 1) + (n >> 4)) + 8 * ((n >> 2) & 3) + 4 * (rperm & 1) + (n & 3));
        { const int rt = drow & 255, rw = rt & 127, sg = rw & 31, R = (rw & ~31) + 16 * ((sg >> 2) & 1) + 4 * (sg >> 3) + (sg & 3);
          const size_t blk = ((size_t)(drow >> 8) * (c.dst_ld >> 6) + ((c.dk0 + c.k0) >> 6)) * 32768 + (size_t)(rt >> 7) * 16384 + (size_t)pg8::lds_byte(R, 8 * kr);
          *(GAS v4u*)((GAS char*)c.dst + blk) = o; } }
}
template <class ItemFn> __device__ __forceinline__ void conv_pipeline(int first, int stride, int count, const ItemFn& item) {
    const int lane = (int)(threadIdx.x & 63);
    int it = first; if (it >= count) return;
    CItem cur = item(it); f32x4 t[8]; ci_load(cur, t, lane);
    for (;;) { const int nx = it + stride; const bool more = nx < count; CItem nxt = cur; f32x4 u[8];
        if (more) { nxt = item(nx); ci_load(nxt, u, lane); }
        ci_store(cur, t, lane);
        if (!more) break;
        cur = nxt; it = nx;
#pragma unroll
        for (int i = 0; i < 8; ++i) t[i] = u[i]; }
}
__device__ __forceinline__ void phase_prologue(Frame& F, bool late_ffn) {
    {
        LAS float* sv = (LAS float*)(F.lds);
        for (int unit = F.bid; unit < 256; unit += F.G) {
            const int ks = unit >> 3, cs = unit & 7;
            __syncthreads();
            if ((int)threadIdx.x < 320) { const int r = (int)threadIdx.x >> 6, kk = (int)threadIdx.x & 63; const float v = r < 4 ? F.c[r * D + ks * 64 + kk] : F.c_ctx[ks * 64 + kk]; sv[(int)threadIdx.x] = v / (1.f + __expf(-v)); }
            __syncthreads();
            float a[5][3];
#pragma unroll
            for (int r = 0; r < 5; ++r)
#pragma unroll
                for (int j = 0; j < 3; ++j) a[r][j] = 0.f;
            const float* wp = F.w_ada + (size_t)(ks * 64) * NMOD + cs * 1536 + (int)threadIdx.x;
#pragma unroll 4
            for (int kk = 0; kk < 64; ++kk) {
                const float w0 = wp[(size_t)kk * NMOD], w1 = wp[(size_t)kk * NMOD + 512], w2 = wp[(size_t)kk * NMOD + 1024];
#pragma unroll
                for (int r = 0; r < 5; ++r) { const float s = sv[r * 64 + kk]; a[r][0] += s * w0; a[r][1] += s * w1; a[r][2] += s * w2; }
            }
#pragma unroll
            for (int r = 0; r < 5; ++r)
#pragma unroll
                for (int j = 0; j < 3; ++j) F.MODP[((size_t)ks * 5 + r) * NMOD + cs * 1536 + (int)threadIdx.x + 512 * j] = a[r][j];
        }
        __syncthreads();
    }
    for (int i = F.bid * 512 + (int)threadIdx.x; i < 128 * 32; i += F.G * 512) { const int pos = i >> 5, f = i & 31; const float inv = powf(10000.0f, -(float)f / 32.0f); const float ang = (float)pos * inv; F.ROPE[i] = cosf(ang); F.ROPE[4096 + i] = sinf(ang); }
    const int gw = F.bid * NWAVES + F.wave, NGW = F.G * NWAVES;
    constexpr int I_IN = 32 * 424, I_AP = 32 * 64, I_MP = 32 * 64, I_OUT = 32 * 64, I_FFI = 32 * 352, I_FFO = 88 * 64;
    const int NITEMS = late_ffn ? (I_IN + I_AP + I_MP + I_OUT) : (I_IN + I_AP + I_MP + I_OUT + I_FFI + I_FFO);
    conv_pipeline(gw, NGW, NITEMS, [&](int it) -> CItem { int r = it; CItem c; c.dk0 = 0; c.rperm = -1; c.scale = 1.f;
        if (r < I_IN) { const int kb = r / 424, nb = r % 424; int src;
            c.src = F.w_in; c.src_ld = W_IN_COLS; c.k0 = 64 * kb; c.dst = F.WIN; c.dst_ld = D; c.drow0 = 32 * nb;
            if (nb < 128) { src = 32 * nb; if (nb < 16) { c.rperm = nb & 3; c.drow0 = 128 * (nb >> 2); } }
            else if (nb < 192) { src = 4128 + 32 * (nb - 128); c.scale = QSCALE; c.rperm = (nb - 128) & 3; c.drow0 = 4096 + 128 * ((nb - 128) >> 2); }
            else if (nb < 224) { src = 6176 + 32 * (nb - 192); c.scale = QSCALE; } else if (nb < 416) src = 7200 + 32 * (nb - 224); else if (nb == 416) src = 4096; else { src = 0; c.src = nullptr; }
            c.c0 = src; return c; }
        r -= I_IN;
        if (r < I_AP) { c.src = F.w_attn_proj; c.src_ld = D; c.k0 = 64 * (r / 64); c.c0 = 32 * (r % 64); c.dst = F.WAM; c.dst_ld = 4096; c.drow0 = 32 * (r % 64); return c; } r -= I_AP;
        if (r < I_MP) { c.src = F.w_mlstm_proj; c.src_ld = D; c.k0 = 64 * (r / 64); c.c0 = 32 * (r % 64); c.dst = F.WAM; c.dst_ld = 4096; c.drow0 = 32 * (r % 64); c.dk0 = 2048; return c; } r -= I_MP;
        if (r < I_OUT) { c.src = F.w_out; c.src_ld = D; c.k0 = 64 * (r / 64); c.c0 = 32 * (r % 64); c.dst = F.WOUT; c.dst_ld = D; c.drow0 = 32 * (r % 64); return c; } r -= I_OUT;
        if (r < I_FFI) { const int kb = r / 352, nb = r % 352, pn = nb >> 3, w = nb & 7;
            c.src = F.w_ffn_in; c.src_ld = 2 * DFF; c.k0 = 64 * kb; c.c0 = (w < 4) ? (128 * pn + 32 * w) : (DFF + 128 * pn + 32 * (w - 4)); c.dst = F.WFFI; c.dst_ld = D; c.drow0 = 32 * nb; return c; }
        r -= I_FFI;
        c.src = F.w_ffn_out; c.src_ld = D; c.k0 = 64 * (r / 64); c.c0 = 32 * (r % 64); c.dst = F.WFFO; c.dst_ld = DFF; c.drow0 = 32 * (r % 64); return c; });
}
__device__ __forceinline__ void norm_mod_rows_b(Frame& F, const bf16* X, int row_lo, int row_hi, const float* g, bf16* O, int chunk_shift, int chunk_scale) {
    const int lane = (int)(threadIdx.x & 63); int cur_b = -1; f32x4 ca[4][2], cb[4][2];
    if (row_lo >= row_hi) return;
    v4u nx[4];
    { const GAS v4u* xr = (const GAS v4u*)(X + (size_t)row_lo * D) + lane;
#pragma unroll
      for (int j = 0; j < 4; ++j) nx[j] = xr[64 * j]; }
    for (int row = row_lo; row < row_hi; ++row) {
        const int b = row >> 13;
        if (b != cur_b) { cur_b = b; const float* mp = F.MOD + (size_t)b * NMOD;
#pragma unroll
            for (int j = 0; j < 4; ++j)
#pragma unroll
                for (int hh = 0; hh < 2; ++hh) { const int c = 8 * (64 * j + lane) + 4 * hh; const f32x4 gg = *(const GAS f32x4*)(g + c), sc = *(const GAS f32x4*)(mp + chunk_scale * D + c); ca[j][hh] = gg * (sc + 1.0f); cb[j][hh] = *(const GAS f32x4*)(mp + chunk_shift * D + c); } }
        v4u cur[4];
#pragma unroll
        for (int j = 0; j < 4; ++j) cur[j] = nx[j];
        if (row + 1 < row_hi) { const GAS v4u* xr = (const GAS v4u*)(X + (size_t)(row + 1) * D) + lane;
#pragma unroll
            for (int j = 0; j < 4; ++j) nx[j] = xr[64 * j]; }
        f32x4 v[4][2]; float s = 0.f;
#pragma unroll
        for (int j = 0; j < 4; ++j) { const v4u w = cur[j]; v[j][0] = (f32x4){bflo(w.x), bfhi(w.x), bflo(w.y), bfhi(w.y)}; v[j][1] = (f32x4){bflo(w.z), bfhi(w.z), bflo(w.w), bfhi(w.w)};
            s += (v[j][0].x * v[j][0].x + v[j][0].y * v[j][0].y) + (v[j][0].z * v[j][0].z + v[j][0].w * v[j][0].w) + (v[j][1].x * v[j][1].x + v[j][1].y * v[j][1].y) + (v[j][1].z * v[j][1].z + v[j][1].w * v[j][1].w); }
        const float r = __builtin_amdgcn_rsqf(wave_sum_dpp(s) * (1.0f / D) + NORM_EPS);
        GAS v4u* o16 = (GAS v4u*)(O + ((((size_t)(row >> 8) * 32 + (lane >> 3)) * 256 + (row & 255)) << 6) + 8 * (lane & 7));
#pragma unroll
        for (int j = 0; j < 4; ++j) { const f32x4 y0 = (v[j][0] * r) * ca[j][0] + cb[j][0], y1 = (v[j][1] * r) * ca[j][1] + cb[j][1]; v4u w; w.x = pg8::cvt_pk_bf16(y0.x, y0.y); w.y = pg8::cvt_pk_bf16(y0.z, y0.w); w.z = pg8::cvt_pk_bf16(y1.x, y1.y); w.w = pg8::cvt_pk_bf16(y1.z, y1.w); o16[(size_t)j * 8 * 256 * 64 / 8] = w; }
    }
}
__device__ __forceinline__ void convert_ffn_weights_queue(Frame& F) {
    constexpr int I_FFI = 32 * 352, I_FFO = 88 * 64, TOTAL = I_FFI + I_FFO, BATCH = 8;
    unsigned* qh = (unsigned*)(F.ctl + CW_QUEUE);
    auto item = [&](int r) -> CItem { CItem c; c.dk0 = 0; c.rperm = -1; c.scale = 1.f;
        if (r < I_FFI) { const int kb = r / 352, nb = r % 352, pn = nb >> 3, w = nb & 7;
            c.src = F.w_ffn_in; c.src_ld = 2 * DFF; c.k0 = 64 * kb; c.c0 = (w < 4) ? (128 * pn + 32 * w) : (DFF + 128 * pn + 32 * (w - 4)); c.dst = F.WFFI; c.dst_ld = D; c.drow0 = 32 * nb; return c; }
        const int r2 = r - I_FFI; c.src = F.w_ffn_out; c.src_ld = D; c.k0 = 64 * (r2 / 64); c.c0 = 32 * (r2 % 64); c.dst = F.WFFO; c.dst_ld = DFF; c.drow0 = 32 * (r2 % 64); return c; };
    auto grab = [&]() -> int { unsigned v = 0u; if ((threadIdx.x & 63) == 0) v = xb_add(qh, (unsigned)BATCH); return (int)__builtin_amdgcn_readfirstlane(v); };
    int base = grab();
    while (base < TOTAL) { const int nextb = grab(); const int end = base + BATCH < TOTAL ? base + BATCH : TOTAL; conv_pipeline(base, 1, end, item); base = nextb; }
}
__device__ __forceinline__ void phase_mod_reduce(Frame& F) {
    for (int e = F.bid * 512 + (int)threadIdx.x; e < 5 * NMOD; e += F.G * 512) { const int n = e % NMOD; float s = F.b_ada[n];
#pragma unroll 8
        for (int ks = 0; ks < 32; ++ks) s += F.MODP[(size_t)ks * 5 * NMOD + e];
        F.MOD[e] = s; }
}
__device__ __forceinline__ void norm_mod_rows(Frame& F, const float* X, int row_lo, int row_hi, const float* g, bf16* O, int chunk_shift, int chunk_scale, bool ctx_tail) {
    const int lane = (int)(threadIdx.x & 63); int cur_b = -1; f32x4 ca[8], cb[8];
    if (row_lo >= row_hi) return;
    f32x4 nx[8];
    { const float* xr = (ctx_tail && row_lo >= MLAT) ? (F.ctx + (size_t)(row_lo - MLAT) * D) : (X + (size_t)row_lo * D);
#pragma unroll
      for (int j = 0; j < 8; ++j) nx[j] = *(const GAS f32x4*)(xr + 256 * j + 4 * lane); }
    for (int row = row_lo; row < row_hi; ++row) {
        const int b = (ctx_tail && row >= MLAT) ? 4 : (row >> 13);
        if (b != cur_b) { cur_b = b; const float* mp = F.MOD + (size_t)b * NMOD;
#pragma unroll
            for (int j = 0; j < 8; ++j) { const f32x4 gg = *(const GAS f32x4*)(g + 256 * j + 4 * lane), sc = *(const GAS f32x4*)(mp + chunk_scale * D + 256 * j + 4 * lane); ca[j] = gg * (sc + 1.0f); cb[j] = *(const GAS f32x4*)(mp + chunk_shift * D + 256 * j + 4 * lane); } }
        f32x4 v[8]; float s = 0.f;
#pragma unroll
        for (int j = 0; j < 8; ++j) v[j] = nx[j];
        if (row + 1 < row_hi) { const int rn = row + 1; const float* xr = (ctx_tail && rn >= MLAT) ? (F.ctx + (size_t)(rn - MLAT) * D) : (X + (size_t)rn * D);
#pragma unroll
            for (int j = 0; j < 8; ++j) nx[j] = *(const GAS f32x4*)(xr + 256 * j + 4 * lane); }
#pragma unroll
        for (int j = 0; j < 8; ++j) s += (v[j].x * v[j].x + v[j].y * v[j].y) + (v[j].z * v[j].z + v[j].w * v[j].w);
        const float r = __builtin_amdgcn_rsqf(wave_sum_dpp(s) * (1.0f / D) + NORM_EPS);
        GAS v2u* o8 = (GAS v2u*)(O + ((((size_t)(row >> 8) * 32 + (lane >> 4)) * 256 + (row & 255)) << 6) + 4 * (lane & 15));
#pragma unroll
        for (int j = 0; j < 8; ++j) { const f32x4 y = (v[j] * r) * ca[j] + cb[j]; v2u w; w.x = pg8::cvt_pk_bf16(y.x, y.y); w.y = pg8::cvt_pk_bf16(y.z, y.w); o8[(size_t)j * 4 * 256 * 64 / 4] = w; }
    }
}
__device__ __forceinline__ void phase_gate_scan(Frame& F) {
    const int gw = F.bid * NWAVES + F.wave, NGW = F.G * NWAVES, lane = (int)(threadIdx.x & 63);
    for (int task = gw; task < 64 * 66; task += NGW) {
        const int bhd = task / 66, ci = task % 66, dir = bhd & 1, h = (bhd >> 1) & 7, b = bhd >> 4;
        const bool lat = ci >= 2; const int ac = lat ? (dir ? 63 - (ci - 2) : (ci - 2)) : (dir ? 1 - ci : ci);
        const size_t gr = lat ? ((size_t)b * SEQ + 128 * ac) : ((size_t)MLAT + (size_t)b * CL + 128 * ac);
        const float bi = F.b_gates[dir * 16 + h], bfg = F.b_gates[dir * 16 + 8 + h];
        float l[2], f[2];
#pragma unroll
        for (int e = 0; e < 2; ++e) { const int p = 2 * lane + e; const int t = dir ? 127 - p : p; const float* gp = F.GATES + (gr + t) * 32 + dir * 16 + h; l[e] = gp[0] + bi; const float z = gp[8] + bfg;
            f[e] = z >= 0.f ? -log1pf(expf(-z)) : z - log1pf(expf(z)); }
        float sc = f[0] + f[1];
#pragma unroll
        for (int o = 1; o < 64; o <<= 1) { const float t = __shfl_up(sc, o); if (lane >= o) sc += t; }
        const float b1 = sc, b0 = sc - f[1], u0 = l[0] - b0, u1 = l[1] - b1;
        const float umax = wave_max(fmaxf(u0, u1)), bend = __shfl(b1, 63);
        const size_t o = (size_t)bhd * 8448 + ci * 128 + 2 * lane;
        *(GAS v2u*)(F.GU + o) = (v2u){__builtin_bit_cast(unsigned, u0), __builtin_bit_cast(unsigned, u1)};
        *(GAS v2u*)(F.GB + o) = (v2u){__builtin_bit_cast(unsigned, b0), __builtin_bit_cast(unsigned, b1)};
        if (lane == 0) { F.GS[(size_t)task * 2] = umax; F.GS[(size_t)task * 2 + 1] = bend; }
    }
}
namespace attn {
using bf16x8 = __attribute__((ext_vector_type(8))) short;
using s16x4  = __attribute__((ext_vector_type(4))) short;
using f32x16 = __attribute__((ext_vector_type(16))) float;
using u32x4  = __attribute__((ext_vector_type(4))) unsigned;
constexpr int QBLK = 32, KVBLK = 64, LDK = 512, LDQ = 4096;
constexpr float THR = 6.f;
constexpr int SHM_V = KVBLK * 128 * 2, SHM_K = KVBLK * 128 * 2, SHM_ATTN = 2 * SHM_V + 2 * SHM_K + 8 * 64 * 4;
#define KSWZ(row, colB) ((row) * 256 + ((colB) ^ (((row) & 7) << 4)))
#define SBAR() __builtin_amdgcn_sched_barrier(0)
__device__ __forceinline__ int crow(int r, int hi) { return (r & 3) + 8 * (r >> 2) + 4 * hi; }
__device__ __forceinline__ unsigned cvtpk(float lo, float hi) { unsigned r; asm volatile("v_cvt_pk_bf16_f32 %0, %1, %2" : "=v"(r) : "v"(lo), "v"(hi)); return r; }
__device__ __forceinline__ void partialSM(f32x16& p0, f32x16& p1, float& m_reg, float& mn, float& alpha) {
  constexpr float C = 1.4426950408889634f;
  float pmax = p0[0]; for (int r = 1; r < 16; ++r) pmax = fmaxf(pmax, p0[r]); for (int r = 0; r < 16; ++r) pmax = fmaxf(pmax, p1[r]);
  { auto rr = __builtin_amdgcn_permlane32_swap(__float_as_uint(pmax), __float_as_uint(pmax), false, false);
    pmax = fmaxf(__uint_as_float(rr[0]), __uint_as_float(rr[1])); }
  if (__builtin_expect(__all(pmax - m_reg <= THR), 1)) { mn = m_reg; alpha = 1.f; }
  else { mn = fmaxf(m_reg, pmax); alpha = __builtin_amdgcn_exp2f((m_reg - mn) * C); m_reg = mn; }
  float mnC = -mn * C;
  for (int r = 0; r < 16; ++r) p0[r] = fmaf(p0[r], C, mnC); for (int r = 0; r < 16; ++r) p1[r] = fmaf(p1[r], C, mnC);
  for (int r = 0; r < 16; ++r) p0[r] = __builtin_amdgcn_exp2f(p0[r]);
}
__device__ __forceinline__ void finishSM(f32x16& p0, f32x16& p1, float alpha, float& l_reg, bf16x8& pa0, bf16x8& pa1, bf16x8& pa2, bf16x8& pa3) {
  for (int r = 0; r < 16; ++r) p1[r] = __builtin_amdgcn_exp2f(p1[r]);
  float ps = 0; for (int r = 0; r < 16; ++r) ps += p0[r]; for (int r = 0; r < 16; ++r) ps += p1[r];
  { auto rr = __builtin_amdgcn_permlane32_swap(__float_as_uint(ps), __float_as_uint(ps), false, false);
    ps = __uint_as_float(rr[0]) + __uint_as_float(rr[1]); }
  l_reg = l_reg * alpha + ps;
#define PK4(P, BASE, OUT) do { unsigned a0 = cvtpk(P[BASE + 0], P[BASE + 1]), a1 = cvtpk(P[BASE + 2], P[BASE + 3]);   \
    unsigned b0 = cvtpk(P[BASE + 4], P[BASE + 5]), b1 = cvtpk(P[BASE + 6], P[BASE + 7]);                              \
    auto r0 = __builtin_amdgcn_permlane32_swap(a0, b0, false, false); auto r1 = __builtin_amdgcn_permlane32_swap(a1, b1, false, false); \
    u32x4 w = {r0[0], r1[0], r0[1], r1[1]}; OUT = *reinterpret_cast<bf16x8*>(&w); } while (0)
  PK4(p0, 0, pa0); PK4(p0, 8, pa1); PK4(p1, 0, pa2); PK4(p1, 8, pa3);
#undef PK4
}
template <int OFF> __device__ __forceinline__ f32x4 ldk128(int a) { f32x4 r; asm volatile("ds_read_b128 %0, %1 offset:%2" : "=&v"(r) : "v"(a), "i"(OFF) : "memory"); return r; }
__device__ __forceinline__ void qkt(f32x16& p0, f32x16& p1, const bf16* Ks, const bf16x8* qr, int r32, int hi) {
  const int rowb = (int)(uintptr_t)Ks + r32 * 256, y = (16 * hi) ^ ((r32 & 7) << 4);
  f32x4 f0, f1, f2; const f32x16 z16 = f32x16{};
#define QK_ADDR(D0) (rowb + (y ^ (32 * (D0))))
#define QK_WAIT(n, F) asm volatile("s_waitcnt lgkmcnt(" #n ")" : "+v"(F) :: "memory")
  f0 = ldk128<0>(QK_ADDR(0)); f1 = ldk128<8192>(QK_ADDR(0));
  f2 = ldk128<0>(QK_ADDR(1)); QK_WAIT(2, f0); p0 = __builtin_amdgcn_mfma_f32_32x32x16_bf16(__builtin_bit_cast(bf16x8, f0), qr[0], z16, 0, 0, 0);
  f0 = ldk128<8192>(QK_ADDR(1)); QK_WAIT(2, f1); p1 = __builtin_amdgcn_mfma_f32_32x32x16_bf16(__builtin_bit_cast(bf16x8, f1), qr[0], z16, 0, 0, 0);
  f1 = ldk128<0>(QK_ADDR(2)); QK_WAIT(2, f2); p0 = __builtin_amdgcn_mfma_f32_32x32x16_bf16(__builtin_bit_cast(bf16x8, f2), qr[1], p0, 0, 0, 0);
  f2 = ldk128<8192>(QK_ADDR(2)); QK_WAIT(2, f0); p1 = __builtin_amdgcn_mfma_f32_32x32x16_bf16(__builtin_bit_cast(bf16x8, f0), qr[1], p1, 0, 0, 0);
  f0 = ldk128<0>(QK_ADDR(3)); QK_WAIT(2, f1); p0 = __builtin_amdgcn_mfma_f32_32x32x16_bf16(__builtin_bit_cast(bf16x8, f1), qr[2], p0, 0, 0, 0);
  f1 = ldk128<8192>(QK_ADDR(3)); QK_WAIT(2, f2); p1 = __builtin_amdgcn_mfma_f32_32x32x16_bf16(__builtin_bit_cast(bf16x8, f2), qr[2], p1, 0, 0, 0);
  f2 = ldk128<0>(QK_ADDR(4)); QK_WAIT(2, f0); p0 = __builtin_amdgcn_mfma_f32_32x32x16_bf16(__builtin_bit_cast(bf16x8, f0), qr[3], p0, 0, 0, 0);
  f0 = ldk128<8192>(QK_ADDR(4)); QK_WAIT(2, f1); p1 = __builtin_amdgcn_mfma_f32_32x32x16_bf16(__builtin_bit_cast(bf16x8, f1), qr[3], p1, 0, 0, 0);
  f1 = ldk128<0>(QK_ADDR(5)); QK_WAIT(2, f2); p0 = __builtin_amdgcn_mfma_f32_32x32x16_bf16(__builtin_bit_cast(bf16x8, f2), qr[4], p0, 0, 0, 0);
  f2 = ldk128<8192>(QK_ADDR(5)); QK_WAIT(2, f0); p1 = __builtin_amdgcn_mfma_f32_32x32x16_bf16(__builtin_bit_cast(bf16x8, f0), qr[4], p1, 0, 0, 0);
  f0 = ldk128<0>(QK_ADDR(6)); QK_WAIT(2, f1); p0 = __builtin_amdgcn_mfma_f32_32x32x16_bf16(__builtin_bit_cast(bf16x8, f1), qr[5], p0, 0, 0, 0);
  f1 = ldk128<8192>(QK_ADDR(6)); QK_WAIT(2, f2); p1 = __builtin_amdgcn_mfma_f32_32x32x16_bf16(__builtin_bit_cast(bf16x8, f2), qr[5], p1, 0, 0, 0);
  f2 = ldk128<0>(QK_ADDR(7)); QK_WAIT(2, f0); p0 = __builtin_amdgcn_mfma_f32_32x32x16_bf16(__builtin_bit_cast(bf16x8, f0), qr[6], p0, 0, 0, 0);
  f0 = ldk128<8192>(QK_ADDR(7)); QK_WAIT(2, f1); p1 = __builtin_amdgcn_mfma_f32_32x32x16_bf16(__builtin_bit_cast(bf16x8, f1), qr[6], p1, 0, 0, 0);
  QK_WAIT(1, f2); p0 = __builtin_amdgcn_mfma_f32_32x32x16_bf16(__builtin_bit_cast(bf16x8, f2), qr[7], p0, 0, 0, 0);
  QK_WAIT(0, f0); p1 = __builtin_amdgcn_mfma_f32_32x32x16_bf16(__builtin_bit_cast(bf16x8, f0), qr[7], p1, 0, 0, 0);
#undef QK_ADDR
#undef QK_WAIT
}
__device__ __forceinline__ void band_mask(f32x16& p0, f32x16& p1, int kk0, int qi, int hi) {
  for (int r = 0; r < 16; ++r) { const int kk = kk0 + crow(r, hi); p0[r] = (kk >= qi && kk <= qi + 256) ? p0[r] : -1.0e30f; const int k2 = kk + 32; p1[r] = (k2 >= qi && k2 <= qi + 256) ? p1[r] : -1.0e30f; }
}
__device__ __forceinline__ int v_st(int k, int c) { const int kk = (k & ~0xC) | ((k & 4) << 1) | ((k & 8) >> 1); return ((kk >> 3) * 4 + (c >> 5)) * 512 + ((kk & 7) * 32 + (c & 31)) * 2; }
__device__ __forceinline__ int v_rd_base(int lane) { return ((lane & 3) << 3) | (((lane >> 2) & 3) << 6) | (((lane >> 4) & 1) << 5) | (((lane >> 5) & 1) << 8); }
constexpr int v_rd_off(int d0, int ks, int half) { return d0 * 512 + ks * 4096 + half * 2048; }
template <int OFF> __device__ __forceinline__ s16x4 tr_read(int vb) {
  s16x4 r; asm volatile("ds_read_b64_tr_b16 %0, %1 offset:%2" : "=&v"(r) : "v"(vb), "i"(OFF) : "memory"); return r;
}
template <int D0> __device__ __forceinline__ void pv_one(f32x16& od, int vb, bf16x8 pa0, bf16x8 pa1, bf16x8 pa2, bf16x8 pa3) {
  const s16x4 l0 = tr_read<v_rd_off(D0, 0, 0)>(vb), h0 = tr_read<v_rd_off(D0, 0, 1)>(vb), l1 = tr_read<v_rd_off(D0, 1, 0)>(vb), h1 = tr_read<v_rd_off(D0, 1, 1)>(vb);
  const s16x4 l2 = tr_read<v_rd_off(D0, 2, 0)>(vb), h2 = tr_read<v_rd_off(D0, 2, 1)>(vb), l3 = tr_read<v_rd_off(D0, 3, 0)>(vb), h3 = tr_read<v_rd_off(D0, 3, 1)>(vb);
  asm volatile("s_waitcnt lgkmcnt(0)" ::: "memory"); SBAR();
#define PK(L, H) (bf16x8){L[0], L[1], L[2], L[3], H[0], H[1], H[2], H[3]}
  od = __builtin_amdgcn_mfma_f32_32x32x16_bf16(pa0, PK(l0, h0), od, 0, 0, 0);
  od = __builtin_amdgcn_mfma_f32_32x32x16_bf16(pa1, PK(l1, h1), od, 0, 0, 0);
  od = __builtin_amdgcn_mfma_f32_32x32x16_bf16(pa2, PK(l2, h2), od, 0, 0, 0);
  od = __builtin_amdgcn_mfma_f32_32x32x16_bf16(pa3, PK(l3, h3), od, 0, 0, 0);
#undef PK
}
__device__ __forceinline__ void pv_d0(f32x16* o, int vb, bf16x8 pa0, bf16x8 pa1, bf16x8 pa2, bf16x8 pa3) {
  pv_one<0>(o[0], vb, pa0, pa1, pa2, pa3); pv_one<1>(o[1], vb, pa0, pa1, pa2, pa3); pv_one<2>(o[2], vb, pa0, pa1, pa2, pa3); pv_one<3>(o[3], vb, pa0, pa1, pa2, pa3);
}
template <bool STORE> __device__ __forceinline__ void attn_unit(bf16* AM, const bf16* KA, const bf16* VA, const bf16* CKA, const bf16* CVA, const float* sinkp, int b, int g, int qb, int pair, char* lds) {
  const int tid = threadIdx.x, wid = tid >> 6, lane = tid & 63, r32 = lane & 31, hi = lane >> 5;
  bf16* V_lds = (bf16*)lds; bf16* K_lds = (bf16*)(lds + 2 * SHM_V);
  float* ws = (float*)(lds + 2 * SHM_V + 2 * SHM_K) + wid * 64; float* li_l = ws; float* al_l = ws + 32;
  const int head = 4 * g + 2 * pair + (wid >> 2), qrow0 = 32 * (wid & 3), qi = qrow0 + r32;
  float m_reg = sinkp[head], l_reg = 1.f; f32x16 o[4] = {}; bf16x8 qr[8];
  bf16* Qrow = AM + (size_t)(b * SEQ + 128 * qb + qi) * LDQ + head * 128;
  const bf16* Qw = Qrow + hi * 8;
#pragma unroll
  for (int d0 = 0; d0 < 8; ++d0) qr[d0] = *reinterpret_cast<const bf16x8*>(Qw + d0 * 16);
  const int sr = tid >> 4, sc = (tid & 15) * 8, vst0 = v_st(sr, sc), vst1 = v_st(32 + sr, sc);
  const int vb0 = (int)(uintptr_t)V_lds + v_rd_base(lane);
  const int kstart = (qb == 0) ? 128 : 0, nloc = (qb == 0 || qb == SEQ / 128 - 1) ? 4 : 6, NT = nloc + 4;
  const size_t lrow0 = (size_t)(b * SEQ + 128 * (qb - 1) + kstart), crow0 = (size_t)(b * CL);
  struct { bf16x8 vs0, vs1, ks0, ks1; } sr_[1];
#define SLOAD(i, tile) do { const int _t = (tile); const bool _loc = _t < nloc; const size_t _row = _loc ? (lrow0 + 64 * _t) : (crow0 + 64 * (_t - nloc)); \
    const bf16* _kp = (_loc ? KA : CKA) + _row * LDK + g * 128 + sc; const bf16* _vp = (_loc ? VA : CVA) + _row * LDK + g * 128 + sc; \
    sr_[i].vs0 = *reinterpret_cast<const bf16x8*>(_vp + (size_t)sr * LDK); sr_[i].vs1 = *reinterpret_cast<const bf16x8*>(_vp + (size_t)(32 + sr) * LDK); \
    sr_[i].ks0 = *reinterpret_cast<const bf16x8*>(_kp + (size_t)sr * LDK); sr_[i].ks1 = *reinterpret_cast<const bf16x8*>(_kp + (size_t)(32 + sr) * LDK); } while (0)
#define SWRITE(b_, i) do { *(bf16x8*)((char*)V_lds + (b_) * SHM_V + vst0) = sr_[i].vs0;          \
    *(bf16x8*)((char*)V_lds + (b_) * SHM_V + vst1) = sr_[i].vs1; int kc = sc * 2;               \
    *(bf16x8*)((char*)K_lds + (b_) * SHM_K + KSWZ(sr, kc)) = sr_[i].ks0;                       \
    *(bf16x8*)((char*)K_lds + (b_) * SHM_K + KSWZ(32 + sr, kc)) = sr_[i].ks1; } while (0)
#define SWAIT() asm volatile("s_waitcnt vmcnt(0)" ::: "memory")
#define RESC(a) do { if (__any((a) < 1.f)) { if (hi == 0) al_l[r32] = (a); asm volatile("s_waitcnt lgkmcnt(0)" ::: "memory"); \
    for (int d = 0; d < 4; ++d) for (int r = 0; r < 16; ++r) o[d][r] *= al_l[crow(r, hi)]; } } while (0)
#define MASK(P0, P1, tile) do { const int _kk0 = kstart + 64 * (tile); if ((tile) < nloc && (_kk0 < 128 || _kk0 >= 256)) band_mask(P0, P1, _kk0, qi, hi); } while (0)
  f32x16 pA0, pA1, pB0, pB1; float mnA, mnB, alA, alB; bf16x8 pa0, pa1, pa2, pa3;
  SLOAD(0, 0); asm volatile("s_waitcnt vmcnt(0)" ::: "memory"); SWRITE(0, 0); SLOAD(0, 1); __syncthreads();
  qkt(pA0, pA1, K_lds, qr, r32, hi); MASK(pA0, pA1, 0); partialSM(pA0, pA1, m_reg, mnA, alA);
  SWAIT(); SWRITE(1, 0); SLOAD(0, 2); __syncthreads();
  RESC(alA);
  for (int j = 1; j + 1 < NT; j += 2) {
    SBAR(); qkt(pB0, pB1, (bf16*)((char*)K_lds + SHM_K), qr, r32, hi); MASK(pB0, pB1, j);
    finishSM(pA0, pA1, alA, l_reg, pa0, pa1, pa2, pa3); SBAR();
    pv_d0(o, vb0, pa0, pa1, pa2, pa3); partialSM(pB0, pB1, m_reg, mnB, alB);
    __syncthreads(); SWAIT(); SWRITE(0, 0); SLOAD(0, j + 2);
    RESC(alB); __syncthreads();
    SBAR(); qkt(pA0, pA1, K_lds, qr, r32, hi); MASK(pA0, pA1, j + 1);
    finishSM(pB0, pB1, alB, l_reg, pa0, pa1, pa2, pa3); SBAR();
    pv_d0(o, vb0 + (int)SHM_V, pa0, pa1, pa2, pa3); partialSM(pA0, pA1, m_reg, mnA, alA);
    __syncthreads(); SWAIT(); SWRITE(1, 0); if (j + 3 < NT) SLOAD(0, j + 3);
    RESC(alA); __syncthreads();
  }
  SBAR(); qkt(pB0, pB1, (bf16*)((char*)K_lds + SHM_K), qr, r32, hi); MASK(pB0, pB1, NT - 1);
  finishSM(pA0, pA1, alA, l_reg, pa0, pa1, pa2, pa3); SBAR();
  pv_d0(o, vb0, pa0, pa1, pa2, pa3); partialSM(pB0, pB1, m_reg, mnB, alB);
  __syncthreads(); RESC(alB);
  finishSM(pB0, pB1, alB, l_reg, pa0, pa1, pa2, pa3); SBAR();
  pv_d0(o, vb0 + (int)SHM_V, pa0, pa1, pa2, pa3);
  if (hi == 0) li_l[r32] = l_reg; asm volatile("s_waitcnt lgkmcnt(0)" ::: "memory");
  float rli[16];
#pragma unroll
  for (int r = 0; r < 16; ++r) rli[r] = __builtin_amdgcn_rcpf(li_l[crow(r, hi)]);
  bf16* Ow = AM + (size_t)(b * SEQ + 128 * qb + qrow0) * LDQ + head * 128;
  char* ost = lds + SHM_ATTN + wid * (32 * 144);
#pragma unroll
  for (int hf = 0; hf < 2; ++hf) {
#pragma unroll
    for (int r = 0; r < 16; ++r) { const int orow = crow(r, hi);
#pragma unroll
      for (int dd = 0; dd < 2; ++dd) { const float ov = o[2 * hf + dd][r] * rli[r]; *(bf16*)(ost + orow * 144 + (dd * 32 + r32) * 2) = (bf16)f2bf(ov); } }
    asm volatile("s_waitcnt lgkmcnt(0)" ::: "memory");
#pragma unroll
    for (int i = 0; i < 4; ++i) { const int idx = lane + 64 * i, row = idx >> 3, ch = idx & 7; const u32x4 v = *(const u32x4*)(ost + row * 144 + ch * 16);
      if (STORE) *(u32x4*)(Ow + (size_t)row * LDQ + hf * 64 + ch * 8) = v; else asm volatile("" :: "v"(v)); }
    asm volatile("s_waitcnt lgkmcnt(0)" ::: "memory");
  }
  __syncthreads();
#undef SLOAD
#undef SWRITE
#undef SWAIT
#undef RESC
#undef MASK
}
#undef KSWZ
#undef SBAR
}
__device__ __forceinline__ void phase_attn_range(Frame& F, unsigned char* lds_generic, int id0, int n_static) {
    unsigned* qh = (unsigned*)(F.ctl + CW_AQUEUE);
    for (int it = 0;; ++it) { int id;
        if (it < n_static) id = id0 + it;
        else { __syncthreads(); if (threadIdx.x == 0) F.MISC[12] = xb_add(qh, 1u); __syncthreads(); const int k = (int)F.MISC[12]; if (k >= 768) break; id = (k / 6) * 16 + 10 + (k % 6); }
        const int pair = id & 1, qb = (id >> 1) & 63, g = (id >> 7) & 3, b = id >> 9;
        attn::attn_unit<true>(F.AM, F.KA, F.VA, F.CKA, F.CVA, F.attn_sink, b, g, qb, pair, (char*)lds_generic); }
}
template <bool STORE> __device__ __forceinline__ void phase_attn_mfma(Frame& F, unsigned char* lds_generic) {
    const int per = (2048 + F.G - 1) / F.G;
    for (int i = 0; i < per; ++i) { const int id = F.bid * per + i; if (id >= 2048) break;
        const int pair = id & 1, qb = (id >> 1) & 63, g = (id >> 7) & 3, b = id >> 9;
        attn::attn_unit<STORE>(F.AM, F.KA, F.VA, F.CKA, F.CVA, F.attn_sink, b, g, qb, pair, (char*)lds_generic); }
}
namespace ml {
typedef short bf16x8 __attribute__((ext_vector_type(8)));
typedef short s16x4 __attribute__((ext_vector_type(4)));
typedef float f32x2 __attribute__((ext_vector_type(2)));
constexpr int KST = 288, VST = 144, PST = 288, CST = 288;
constexpr int K_OFF = 0, V_OFF = K_OFF + 128 * KST, P_OFF = V_OFF + 128 * VST, CT_OFF = P_OFF + 8 * 16 * PST, AR_OFF = CT_OFF + 80 * CST;
constexpr int AR_BUF = 1024;
constexpr int A_E = 0, A_EM = 512;
constexpr int ML_LDS = AR_OFF + 2 * AR_BUF;
template <int OFF> __device__ __forceinline__ s16x4 trr(int a) { s16x4 r; asm volatile("ds_read_b64_tr_b16 %0, %1 offset:%2" : "=&v"(r) : "v"(a), "i"(OFF) : "memory"); return r; }
template <int OFF> __device__ __forceinline__ f32x4 ldr128(int a) { f32x4 r; asm volatile("ds_read_b128 %0, %1 offset:%2" : "=&v"(r) : "v"(a), "i"(OFF) : "memory"); return r; }
#define ML_PK(L, H) (bf16x8){L[0], L[1], L[2], L[3], H[0], H[1], H[2], H[3]}
__device__ __forceinline__ float bfs(short h) { return __builtin_bit_cast(float, (unsigned)(unsigned short)h << 16); }
__device__ __forceinline__ void mlstm_unit(Frame& F, int unit, unsigned char* ldsg) {
    const int vs = unit & 3, dir = (unit >> 2) & 1, h = (unit >> 3) & 7, b = unit >> 6;
    const int w = F.wave, rb = (w < 4) ? w : 11 - w;
    LAS unsigned char* lds = F.lds;
    const int ldsbase = (int)(uintptr_t)ldsg;
    const float bi = F.b_gates[dir * 16 + h], bfg = F.b_gates[dir * 16 + 8 + h];
    bf16* Hd = dir ? F.H1 : F.H0;
    f32x4 Cst[5];
#pragma unroll
    for (int i = 0; i < 5; ++i) Cst[i] = (f32x4){0.f, 0.f, 0.f, 0.f};
    for (int i = (int)threadIdx.x; i < 80 * CST / 4; i += 512) ((LAS unsigned*)(lds + CT_OFF))[i] = 0u;
    if ((int)threadIdx.x < 128) *(LAS v4u*)(lds + V_OFF + (int)threadIdx.x * VST + 128) = (v4u){0x3f80u, 0u, 0u, 0u};
    v4u kreg[4], vreg[2]; bf16x8 qn[4];
#pragma unroll
    for (int i = 0; i < 4; ++i) qn[i] = (bf16x8){0, 0, 0, 0, 0, 0, 0, 0};
    const int bhd = (b * 8 + h) * 2 + dir;
    const float* GUp = F.GU + (size_t)bhd * 8448; const float* GBp = F.GB + (size_t)bhd * 8448; const float* GSp = F.GS + (size_t)bhd * 132;
    float nu = 0.f, nb = 0.f, n_um, n_be;
    float c_mx, c_a0, c_be;
#define ML_ROWBASE(ci_, RB, LAT) const int _ci = (ci_); const bool LAT = _ci >= 2; const int _ac = LAT ? (dir ? 63 - (_ci - 2) : (_ci - 2)) : (dir ? 1 - _ci : _ci); \
        const size_t RB = LAT ? ((size_t)b * SEQ + 128 * _ac) : ((size_t)b * CL + 128 * _ac);
#define ML_QFETCH(ci_) do { const int _cq = (ci_) >= 2 ? (ci_) : 2; ML_ROWBASE(_cq, _rb, _lat) const int _p = 16 * rb + li; const int _t = dir ? 127 - _p : _p; \
        const bf16* _qp = F.MQ + (_rb + _t) * 1024 + h * 128 + 8 * q; \
        _Pragma("unroll") for (int _k = 0; _k < 4; ++_k) qn[_k] = *(const GAS bf16x8*)(_qp + 32 * _k); } while (0)
#define ML_PREFETCH(ci_) do { ML_ROWBASE(ci_, _rb, _lat) \
        const bf16* _ks = (_lat ? F.MK : F.CMK) + h * 128; const bf16* _vs = (_lat ? F.MV : F.CMV) + h * 256 + vs * 64; \
        _Pragma("unroll") for (int _i = 0; _i < 4; ++_i) { const int _id = tid + 512 * _i, _row = _id >> 4, _cc = _id & 15; const int _t = dir ? 127 - _row : _row; kreg[_i] = *(const GAS v4u*)(_ks + (_rb + _t) * 1024 + 8 * _cc); } \
        _Pragma("unroll") for (int _i = 0; _i < 2; ++_i) { const int _id = tid + 512 * _i, _row = _id >> 3, _cc = _id & 7; const int _t = dir ? 127 - _row : _row; vreg[_i] = *(const GAS v4u*)(_vs + (_rb + _t) * 2048 + 8 * _cc); } \
    } while (0)
    { const int tid = (int)threadIdx.x; ML_PREFETCH(0);
      const float um0 = GSp[0]; c_be = GSp[1]; c_mx = fmaxf(0.f, um0); c_a0 = __expf(0.f - c_mx);
      if (tid < 128) { const float u = GUp[tid], bb = GBp[tid]; LAS float* A0 = (LAS float*)(lds + AR_OFF); A0[A_E / 4 + tid] = __expf(u - c_mx); A0[A_EM / 4 + tid] = __expf(-(bb + c_mx)); nu = GUp[128 + tid]; nb = GBp[128 + tid]; }
      n_um = GSp[2]; n_be = GSp[3]; }
    __syncthreads();
    for (int ci = 0; ci < 66; ++ci) {
        const bool lat = ci >= 2;
        const int ac = lat ? (dir ? 63 - (ci - 2) : (ci - 2)) : 0;
        int tid = (int)threadIdx.x; asm volatile("" : "+v"(tid));
        const int lane = tid & 63, li = lane & 15, q = lane >> 4;
        LAS unsigned char* Pw = lds + P_OFF + w * 16 * PST;
        LAS float* AR = (LAS float*)(lds + AR_OFF + (ci & 1) * AR_BUF);
        const int kbase = ldsbase + K_OFF + (4 * q + (li >> 2)) * KST + (16 * w + 4 * (li & 3)) * 2;
        const int vbase = ldsbase + V_OFF + (4 * q + (li >> 2)) * VST + (4 * (li & 3)) * 2;
#pragma unroll
        for (int i = 0; i < 4; ++i) { const int id = tid + 512 * i, row = id >> 4, cc = id & 15; const float e = AR[A_E / 4 + row]; const v4u kv = kreg[i]; v4u ke;
            ke.x = pg8::cvt_pk_bf16(bflo(kv.x) * e, bfhi(kv.x) * e); ke.y = pg8::cvt_pk_bf16(bflo(kv.y) * e, bfhi(kv.y) * e); ke.z = pg8::cvt_pk_bf16(bflo(kv.z) * e, bfhi(kv.z) * e); ke.w = pg8::cvt_pk_bf16(bflo(kv.w) * e, bfhi(kv.w) * e);
            *(LAS v4u*)(lds + K_OFF + row * KST + cc * 16) = ke; }
#pragma unroll
        for (int i = 0; i < 2; ++i) { const int id = tid + 512 * i, row = id >> 3, cc = id & 7; *(LAS v4u*)(lds + V_OFF + row * VST + cc * 16) = vreg[i]; }
        bf16x8 qf[4];
#pragma unroll
        for (int i = 0; i < 4; ++i) qf[i] = qn[i];
        asm volatile("s_waitcnt lgkmcnt(0)" ::: "memory"); __builtin_amdgcn_s_barrier(); asm volatile("" ::: "memory");
        const float bend = c_be, mx = c_mx, a0 = c_a0;
        if (ci + 1 < 66) {
            const float m0n = bend + mx, mxn = fmaxf(m0n, n_um);
            if (tid < 128) { LAS float* A1 = (LAS float*)(lds + AR_OFF + ((ci + 1) & 1) * AR_BUF); A1[A_E / 4 + tid] = __expf(nu - mxn); A1[A_EM / 4 + tid] = __expf(-(nb + mxn)); }
            c_mx = mxn; c_a0 = __expf(m0n - mxn); c_be = n_be;
        }
        { const int cn = ci + 1 < 66 ? ci + 1 : 65; ML_PREFETCH(cn); ML_QFETCH(cn); }
        { const int c2 = ci + 2 < 66 ? ci + 2 : 65; const int tq = tid & 127; nu = GUp[c2 * 128 + tq]; nb = GBp[c2 * 128 + tq]; const float* gsv = GSp + 2 * c2 + (tid >> 20); n_um = gsv[0]; n_be = gsv[1]; }
        f32x4 acc[5], dl[5];
#pragma unroll
        for (int i = 0; i < 5; ++i) { acc[i] = (f32x4){0.f, 0.f, 0.f, 0.f}; dl[i] = acc[i]; }
        const int prow = 16 * rb + li;
        f32x4 st[8];
#pragma unroll
        for (int i = 0; i < 8; ++i) st[i] = (f32x4){0.f, 0.f, 0.f, 0.f};
        if (lat) {
#define ML_LDK(dst, sb_) do { _Pragma("unroll") for (int ks = 0; ks < 4; ++ks) dst[ks] = *(const LAS bf16x8*)(lds + K_OFF + (16 * (sb_) + li) * KST + (32 * ks + 8 * q) * 2); } while (0)
#define ML_SBLK(cur, nxt, sb_) do { if ((sb_) <= rb) { if ((sb_) + 1 <= rb && (sb_) + 1 < 8) ML_LDK(nxt, (sb_) + 1); \
                _Pragma("unroll") for (int ks = 0; ks < 4; ++ks) st[sb_] = __builtin_amdgcn_mfma_f32_16x16x32_bf16(cur[ks], qf[ks], st[sb_], 0, 0, 0); \
                if ((sb_) == rb) { _Pragma("unroll") for (int r = 0; r < 4; ++r) st[sb_][r] = (4 * q + r <= li) ? st[sb_][r] : 0.f; } } } while (0)
            { bf16x8 kfA[4], kfB[4]; ML_LDK(kfA, 0);
              ML_SBLK(kfA, kfB, 0); ML_SBLK(kfB, kfA, 1); ML_SBLK(kfA, kfB, 2); ML_SBLK(kfB, kfA, 3); ML_SBLK(kfA, kfB, 4); ML_SBLK(kfB, kfA, 5); ML_SBLK(kfA, kfB, 6); ML_SBLK(kfB, kfA, 7); }
#undef ML_SBLK
#undef ML_LDK
#define ML_LDC(dst, ks_) do { _Pragma("unroll") for (int vb = 0; vb < 5; ++vb) dst[vb] = *(const LAS bf16x8*)(lds + CT_OFF + (16 * vb + li) * CST + (32 * (ks_) + 8 * q) * 2); } while (0)
#define ML_QCM(src, ks_) do { _Pragma("unroll") for (int vb = 0; vb < 5; ++vb) acc[vb] = __builtin_amdgcn_mfma_f32_16x16x32_bf16(src[vb], qf[ks_], acc[vb], 0, 0, 0); } while (0)
            { bf16x8 cA[5], cB[5]; ML_LDC(cA, 0); ML_LDC(cB, 1); ML_QCM(cA, 0); ML_LDC(cA, 2); ML_QCM(cB, 1); ML_LDC(cB, 3); ML_QCM(cA, 2); ML_QCM(cB, 3); }
#undef ML_LDC
#undef ML_QCM
#pragma unroll
            for (int vb = 0; vb < 5; ++vb) acc[vb] = acc[vb] * a0;
        }
#define ML_KLOAD(S, KS) do { \
        S##a0 = trr<(32 * KS) * VST + 0>(vbase);  S##a1 = trr<(32 * KS + 16) * VST + 0>(vbase);  S##b0 = trr<(32 * KS) * VST + 32>(vbase); S##b1 = trr<(32 * KS + 16) * VST + 32>(vbase); \
        S##c0 = trr<(32 * KS) * VST + 64>(vbase); S##c1 = trr<(32 * KS + 16) * VST + 64>(vbase); S##d0 = trr<(32 * KS) * VST + 96>(vbase); S##d1 = trr<(32 * KS + 16) * VST + 96>(vbase); \
        S##o0 = trr<(32 * KS) * VST + 128>(vbase); S##o1 = trr<(32 * KS + 16) * VST + 128>(vbase); \
        S##k0 = trr<(32 * KS) * KST>(kbase); S##k1 = trr<(32 * KS + 16) * KST>(kbase); } while (0)
#define ML_KCOMP(S, KS) do { \
        const bf16x8 v0 = ML_PK(S##a0, S##a1), v1 = ML_PK(S##b0, S##b1), v2 = ML_PK(S##c0, S##c1), v3 = ML_PK(S##d0, S##d1), v4 = ML_PK(S##o0, S##o1); \
        const bf16x8 kte = ML_PK(S##k0, S##k1); \
        if (lat && KS <= (rb >> 1)) { v4u pw; pw.x = pg8::cvt_pk_bf16(st[2 * KS][0], st[2 * KS][1]); pw.y = pg8::cvt_pk_bf16(st[2 * KS][2], st[2 * KS][3]); pw.z = pg8::cvt_pk_bf16(st[2 * KS + 1][0], st[2 * KS + 1][1]); pw.w = pg8::cvt_pk_bf16(st[2 * KS + 1][2], st[2 * KS + 1][3]); \
            const bf16x8 pf = __builtin_bit_cast(bf16x8, pw); \
            acc[0] = __builtin_amdgcn_mfma_f32_16x16x32_bf16(v0, pf, acc[0], 0, 0, 0); acc[1] = __builtin_amdgcn_mfma_f32_16x16x32_bf16(v1, pf, acc[1], 0, 0, 0); \
            acc[2] = __builtin_amdgcn_mfma_f32_16x16x32_bf16(v2, pf, acc[2], 0, 0, 0); acc[3] = __builtin_amdgcn_mfma_f32_16x16x32_bf16(v3, pf, acc[3], 0, 0, 0); \
            acc[4] = __builtin_amdgcn_mfma_f32_16x16x32_bf16(v4, pf, acc[4], 0, 0, 0); } \
        dl[0] = __builtin_amdgcn_mfma_f32_16x16x32_bf16(kte, v0, dl[0], 0, 0, 0); dl[1] = __builtin_amdgcn_mfma_f32_16x16x32_bf16(kte, v1, dl[1], 0, 0, 0); \
        dl[2] = __builtin_amdgcn_mfma_f32_16x16x32_bf16(kte, v2, dl[2], 0, 0, 0); dl[3] = __builtin_amdgcn_mfma_f32_16x16x32_bf16(kte, v3, dl[3], 0, 0, 0); \
        dl[4] = __builtin_amdgcn_mfma_f32_16x16x32_bf16(kte, v4, dl[4], 0, 0, 0); } while (0)
#define ML_WAIT12() do { asm volatile("s_waitcnt lgkmcnt(12)" ::: "memory"); __builtin_amdgcn_sched_barrier(0); } while (0)
#define ML_WAIT0() do { asm volatile("s_waitcnt lgkmcnt(0)" ::: "memory"); __builtin_amdgcn_sched_barrier(0); } while (0)
        { s16x4 Aa0, Aa1, Ab0, Ab1, Ac0, Ac1, Ad0, Ad1, Ao0, Ao1, Ak0, Ak1, Ba0, Ba1, Bb0, Bb1, Bc0, Bc1, Bd0, Bd1, Bo0, Bo1, Bk0, Bk1;
          ML_KLOAD(A, 0); ML_KLOAD(B, 1); ML_WAIT12(); ML_KCOMP(A, 0);
          asm volatile("" ::: "memory"); ML_KLOAD(A, 2); ML_WAIT12(); ML_KCOMP(B, 1);
          asm volatile("" ::: "memory"); ML_KLOAD(B, 3); ML_WAIT12(); ML_KCOMP(A, 2);
          ML_WAIT0(); ML_KCOMP(B, 3); }
#undef ML_KLOAD
#undef ML_KCOMP
#undef ML_WAIT12
#undef ML_WAIT0
        if (lat) {
            const float em = AR[A_EM / 4 + prow];
            const float den = __shfl(acc[4][0], li);
            const float inv = 1.0f / fmaxf(fabsf(den), em);
            asm volatile("s_waitcnt lgkmcnt(0)" ::: "memory");
#pragma unroll
            for (int vb = 0; vb < 4; ++vb) { const f32x4 o = acc[vb] * inv; v2u wv; wv.x = pg8::cvt_pk_bf16(o[0], o[1]); wv.y = pg8::cvt_pk_bf16(o[2], o[3]);
                *(LAS v2u*)(Pw + li * VST + (16 * vb + 4 * q) * 2) = wv; }
            asm volatile("s_waitcnt lgkmcnt(0)" ::: "memory");
            const size_t rb0 = (size_t)b * SEQ + 128 * ac;
#pragma unroll
            for (int i = 0; i < 2; ++i) { const int idx = lane + 64 * i, row = idx >> 3, ch = idx & 7; const v4u ov = *(const LAS v4u*)(Pw + row * VST + ch * 16);
                const int p = 16 * rb + row; const int t = dir ? 127 - p : p; *(GAS v4u*)(Hd + (rb0 + t) * 2048 + h * 256 + vs * 64 + 8 * ch) = ov; }
        }
#pragma unroll
        for (int vb = 0; vb < 5; ++vb) Cst[vb] = Cst[vb] * a0 + dl[vb];
        asm volatile("s_waitcnt lgkmcnt(0)" ::: "memory"); __builtin_amdgcn_s_barrier(); asm volatile("" ::: "memory");
#pragma unroll
        for (int vb = 0; vb < 5; ++vb) { v2u wv; wv.x = pg8::cvt_pk_bf16(Cst[vb][0], Cst[vb][1]); wv.y = pg8::cvt_pk_bf16(Cst[vb][2], Cst[vb][3]); *(LAS v2u*)(lds + CT_OFF + (16 * vb + li) * CST + (16 * w + 4 * q) * 2) = wv; }
    }
    __syncthreads();
#undef ML_PREFETCH
#undef ML_QFETCH
#undef ML_ROWBASE
}

constexpr int WKST = 272, WVST = 272, WCST = 272;
constexpr int WK_OFF = 0, WV_OFF = WK_OFF + 128 * WKST, WCT_OFF = WV_OFF + 128 * WVST, WP_OFF = WCT_OFF + 144 * WCST, WAR_OFF = WP_OFF + 8 * 2304;
constexpr int MLW_LDS = WAR_OFF + 2 * AR_BUF;
static_assert(MLW_LDS <= 131072, "wide mLSTM LDS map");
__device__ __forceinline__ void mlstm_unit_wide(Frame& F, int unit, unsigned char* ldsg) {
    const int vs = unit & 1, dir = (unit >> 1) & 1, h = (unit >> 2) & 7, b = unit >> 5;
    const int w = F.wave, rb = (w < 4) ? w : 11 - w;
    LAS unsigned char* lds = F.lds;
    const int ldsbase = (int)(uintptr_t)ldsg;
    bf16* Hd = dir ? F.H1 : F.H0;
    f32x4 Cst[9];
#pragma unroll
    for (int i = 0; i < 9; ++i) Cst[i] = (f32x4){0.f, 0.f, 0.f, 0.f};
    for (int i = (int)threadIdx.x; i < 144 * WCST / 4; i += 512) ((LAS unsigned*)(lds + WCT_OFF))[i] = 0u;
    if ((int)threadIdx.x < 128) *(LAS v4u*)(lds + WV_OFF + (int)threadIdx.x * WVST + 256) = (v4u){0x3f80u, 0u, 0u, 0u};
    v4u kreg[4], vreg[4]; bf16x8 qn[4];
#pragma unroll
    for (int i = 0; i < 4; ++i) qn[i] = (bf16x8){0, 0, 0, 0, 0, 0, 0, 0};
    const int bhd = (b * 8 + h) * 2 + dir;
    const float* GUp = F.GU + (size_t)bhd * 8448; const float* GBp = F.GB + (size_t)bhd * 8448; const float* GSp = F.GS + (size_t)bhd * 132;
    float nu = 0.f, nb = 0.f, n_um, n_be, c_mx, c_a0, c_be;
#define MLW_ROWBASE(ci_, RB, LAT) const int _ci = (ci_); const bool LAT = _ci >= 2; const int _ac = LAT ? (dir ? 63 - (_ci - 2) : (_ci - 2)) : (dir ? 1 - _ci : _ci); \
        const size_t RB = LAT ? ((size_t)b * SEQ + 128 * _ac) : ((size_t)b * CL + 128 * _ac);
#define MLW_QFETCH(ci_) do { const int _cq = (ci_) >= 2 ? (ci_) : 2; MLW_ROWBASE(_cq, _rb, _lat) const int _p = 16 * rb + li; const int _t = dir ? 127 - _p : _p; \
        const bf16* _qp = F.MQ + (_rb + _t) * 1024 + h * 128 + 8 * q; \
        _Pragma("unroll") for (int _k = 0; _k < 4; ++_k) qn[_k] = *(const GAS bf16x8*)(_qp + 32 * _k); } while (0)
#define MLW_PREFETCH(ci_) do { MLW_ROWBASE(ci_, _rb, _lat) \
        const bf16* _ks = (_lat ? F.MK : F.CMK) + h * 128; const bf16* _vs = (_lat ? F.MV : F.CMV) + h * 256 + vs * 128; \
        _Pragma("unroll") for (int _i = 0; _i < 4; ++_i) { const int _id = tid + 512 * _i, _row = _id >> 4, _cc = _id & 15; const int _t = dir ? 127 - _row : _row; \
            kreg[_i] = *(const GAS v4u*)(_ks + (_rb + _t) * 1024 + 8 * _cc); vreg[_i] = *(const GAS v4u*)(_vs + (_rb + _t) * 2048 + 8 * _cc); } \
    } while (0)
    { const int tid = (int)threadIdx.x; MLW_PREFETCH(0);
      const float um0 = GSp[0]; c_be = GSp[1]; c_mx = fmaxf(0.f, um0); c_a0 = __expf(0.f - c_mx);
      if (tid < 128) { const float u = GUp[tid], bb = GBp[tid]; LAS float* A0 = (LAS float*)(lds + WAR_OFF); A0[A_E / 4 + tid] = __expf(u - c_mx); A0[A_EM / 4 + tid] = __expf(-(bb + c_mx)); nu = GUp[128 + tid]; nb = GBp[128 + tid]; }
      n_um = GSp[2]; n_be = GSp[3]; }
    __syncthreads();
    float en[4];
    { const int tid = (int)threadIdx.x; const LAS float* A0 = (const LAS float*)(lds + WAR_OFF);
#pragma unroll
      for (int i = 0; i < 4; ++i) en[i] = A0[A_E / 4 + ((tid + 512 * i) >> 4)]; }
    for (int ci = 0; ci < 66; ++ci) {
        const bool lat = ci >= 2;
        const int ac = lat ? (dir ? 63 - (ci - 2) : (ci - 2)) : 0;
        int tid = (int)threadIdx.x; asm volatile("" : "+v"(tid));
        const int lane = tid & 63, li = lane & 15, q = lane >> 4;
        LAS unsigned char* Pw = lds + WP_OFF + w * 2304;
        LAS float* AR = (LAS float*)(lds + WAR_OFF + (ci & 1) * AR_BUF);
        const int kbase = ldsbase + WK_OFF + (4 * q + (li >> 2)) * WKST + (16 * w + 4 * (li & 3)) * 2;
        const int vbase = ldsbase + WV_OFF + (4 * q + (li >> 2)) * WVST + (4 * (li & 3)) * 2;
#pragma unroll
        for (int i = 0; i < 4; ++i) { const int id = tid + 512 * i, row = id >> 4, cc = id & 15; const float e = en[i]; const v4u kv = kreg[i]; v4u ke;
            ke.x = pg8::cvt_pk_bf16(bflo(kv.x) * e, bfhi(kv.x) * e); ke.y = pg8::cvt_pk_bf16(bflo(kv.y) * e, bfhi(kv.y) * e); ke.z = pg8::cvt_pk_bf16(bflo(kv.z) * e, bfhi(kv.z) * e); ke.w = pg8::cvt_pk_bf16(bflo(kv.w) * e, bfhi(kv.w) * e);
            *(LAS v4u*)(lds + WK_OFF + row * WKST + cc * 16) = ke; *(LAS v4u*)(lds + WV_OFF + row * WVST + cc * 16) = vreg[i]; }
        bf16x8 qf[4];
#pragma unroll
        for (int i = 0; i < 4; ++i) qf[i] = qn[i];
        asm volatile("s_waitcnt lgkmcnt(0)" ::: "memory"); __builtin_amdgcn_s_barrier(); asm volatile("" ::: "memory");
        const float bend = c_be, mx = c_mx, a0 = c_a0;
        if (ci + 1 < 66) {
            const float m0n = bend + mx, mxn = fmaxf(m0n, n_um);
            if (tid < 128) { LAS float* A1 = (LAS float*)(lds + WAR_OFF + ((ci + 1) & 1) * AR_BUF); A1[A_E / 4 + tid] = __expf(nu - mxn); A1[A_EM / 4 + tid] = __expf(-(nb + mxn)); }
            c_mx = mxn; c_a0 = __expf(m0n - mxn); c_be = n_be;
        }
        { const int cn = ci + 1 < 66 ? ci + 1 : 65; MLW_PREFETCH(cn); MLW_QFETCH(cn); }
        { const int c2 = ci + 2 < 66 ? ci + 2 : 65; const int tq = tid & 127; nu = GUp[c2 * 128 + tq]; nb = GBp[c2 * 128 + tq]; const float* gsv = GSp + 2 * c2 + (tid >> 20); n_um = gsv[0]; n_be = gsv[1]; }
        f32x4 acc[9];
#pragma unroll
        for (int i = 0; i < 9; ++i) acc[i] = (f32x4){0.f, 0.f, 0.f, 0.f};
        const int prow = 16 * rb + li;
        f32x4 st[8];
#pragma unroll
        for (int i = 0; i < 8; ++i) st[i] = (f32x4){0.f, 0.f, 0.f, 0.f};
        if (lat) {
#define MLW_SBLK(sb_) do { if ((sb_) <= rb) { const int kb_ = ldsbase + WK_OFF + (16 * (sb_) + li) * WKST + 16 * q; \
                f32x4 k0_ = ldr128<0>(kb_), k1_ = ldr128<64>(kb_), k2_ = ldr128<128>(kb_), k3_ = ldr128<192>(kb_); \
                asm volatile("s_waitcnt lgkmcnt(3)" : "+v"(k0_) :: "memory"); st[sb_] = __builtin_amdgcn_mfma_f32_16x16x32_bf16(__builtin_bit_cast(bf16x8, k0_), qf[0], (f32x4){0.f, 0.f, 0.f, 0.f}, 0, 0, 0); \
                asm volatile("s_waitcnt lgkmcnt(2)" : "+v"(k1_) :: "memory"); st[sb_] = __builtin_amdgcn_mfma_f32_16x16x32_bf16(__builtin_bit_cast(bf16x8, k1_), qf[1], st[sb_], 0, 0, 0); \
                asm volatile("s_waitcnt lgkmcnt(1)" : "+v"(k2_) :: "memory"); st[sb_] = __builtin_amdgcn_mfma_f32_16x16x32_bf16(__builtin_bit_cast(bf16x8, k2_), qf[2], st[sb_], 0, 0, 0); \
                asm volatile("s_waitcnt lgkmcnt(0)" : "+v"(k3_) :: "memory"); st[sb_] = __builtin_amdgcn_mfma_f32_16x16x32_bf16(__builtin_bit_cast(bf16x8, k3_), qf[3], st[sb_], 0, 0, 0); \
                if ((sb_) == rb) { _Pragma("unroll") for (int r = 0; r < 4; ++r) st[sb_][r] = (4 * q + r <= li) ? st[sb_][r] : 0.f; } } } while (0)
            MLW_SBLK(0); MLW_SBLK(1); MLW_SBLK(2); MLW_SBLK(3); MLW_SBLK(4); MLW_SBLK(5); MLW_SBLK(6); MLW_SBLK(7);
#undef MLW_SBLK
#define MLW_WAITN(n) do { asm volatile("s_waitcnt lgkmcnt(" #n ")" ::: "memory"); __builtin_amdgcn_sched_barrier(0); } while (0)
            { const int cbase = ldsbase + WCT_OFF + li * WCST + 16 * q; f32x4 qc0, qc1, qc2, qc3; const f32x4 qcz = (f32x4){0.f, 0.f, 0.f, 0.f};
#define QC_OFF(S) ((16 * ((S) % 9)) * WCST + 64 * ((S) / 9))
#define QC_MM(SRC, S) acc[(S) % 9] = __builtin_amdgcn_mfma_f32_16x16x32_bf16(__builtin_bit_cast(bf16x8, SRC), qf[(S) / 9], (S) < 9 ? qcz : acc[(S) % 9], 0, 0, 0)
              qc0 = ldr128<QC_OFF(0)>(cbase); qc1 = ldr128<QC_OFF(1)>(cbase); qc2 = ldr128<QC_OFF(2)>(cbase); qc3 = ldr128<QC_OFF(3)>(cbase);
              MLW_WAITN(3); QC_MM(qc0, 0); qc0 = ldr128<QC_OFF(4)>(cbase);
              MLW_WAITN(3); QC_MM(qc1, 1); qc1 = ldr128<QC_OFF(5)>(cbase);
              MLW_WAITN(3); QC_MM(qc2, 2); qc2 = ldr128<QC_OFF(6)>(cbase);
              MLW_WAITN(3); QC_MM(qc3, 3); qc3 = ldr128<QC_OFF(7)>(cbase);
              MLW_WAITN(3); QC_MM(qc0, 4); qc0 = ldr128<QC_OFF(8)>(cbase);
              MLW_WAITN(3); QC_MM(qc1, 5); qc1 = ldr128<QC_OFF(9)>(cbase);
              MLW_WAITN(3); QC_MM(qc2, 6); qc2 = ldr128<QC_OFF(10)>(cbase);
              MLW_WAITN(3); QC_MM(qc3, 7); qc3 = ldr128<QC_OFF(11)>(cbase);
              MLW_WAITN(3); QC_MM(qc0, 8); qc0 = ldr128<QC_OFF(12)>(cbase);
              MLW_WAITN(3); QC_MM(qc1, 9); qc1 = ldr128<QC_OFF(13)>(cbase);
              MLW_WAITN(3); QC_MM(qc2, 10); qc2 = ldr128<QC_OFF(14)>(cbase);
              MLW_WAITN(3); QC_MM(qc3, 11); qc3 = ldr128<QC_OFF(15)>(cbase);
              MLW_WAITN(3); QC_MM(qc0, 12); qc0 = ldr128<QC_OFF(16)>(cbase);
              MLW_WAITN(3); QC_MM(qc1, 13); qc1 = ldr128<QC_OFF(17)>(cbase);
              MLW_WAITN(3); QC_MM(qc2, 14); qc2 = ldr128<QC_OFF(18)>(cbase);
              MLW_WAITN(3); QC_MM(qc3, 15); qc3 = ldr128<QC_OFF(19)>(cbase);
              MLW_WAITN(3); QC_MM(qc0, 16); qc0 = ldr128<QC_OFF(20)>(cbase);
              MLW_WAITN(3); QC_MM(qc1, 17); qc1 = ldr128<QC_OFF(21)>(cbase);
              MLW_WAITN(3); QC_MM(qc2, 18); qc2 = ldr128<QC_OFF(22)>(cbase);
              MLW_WAITN(3); QC_MM(qc3, 19); qc3 = ldr128<QC_OFF(23)>(cbase);
              MLW_WAITN(3); QC_MM(qc0, 20); qc0 = ldr128<QC_OFF(24)>(cbase);
              MLW_WAITN(3); QC_MM(qc1, 21); qc1 = ldr128<QC_OFF(25)>(cbase);
              MLW_WAITN(3); QC_MM(qc2, 22); qc2 = ldr128<QC_OFF(26)>(cbase);
              MLW_WAITN(3); QC_MM(qc3, 23); qc3 = ldr128<QC_OFF(27)>(cbase);
              MLW_WAITN(3); QC_MM(qc0, 24); qc0 = ldr128<QC_OFF(28)>(cbase);
              MLW_WAITN(3); QC_MM(qc1, 25); qc1 = ldr128<QC_OFF(29)>(cbase);
              MLW_WAITN(3); QC_MM(qc2, 26); qc2 = ldr128<QC_OFF(30)>(cbase);
              MLW_WAITN(3); QC_MM(qc3, 27); qc3 = ldr128<QC_OFF(31)>(cbase);
              MLW_WAITN(3); QC_MM(qc0, 28); qc0 = ldr128<QC_OFF(32)>(cbase);
              MLW_WAITN(3); QC_MM(qc1, 29); qc1 = ldr128<QC_OFF(33)>(cbase);
              MLW_WAITN(3); QC_MM(qc2, 30); qc2 = ldr128<QC_OFF(34)>(cbase);
              MLW_WAITN(3); QC_MM(qc3, 31); qc3 = ldr128<QC_OFF(35)>(cbase);
              MLW_WAITN(3); QC_MM(qc0, 32);
              MLW_WAITN(2); QC_MM(qc1, 33);
              MLW_WAITN(1); QC_MM(qc2, 34);
              MLW_WAITN(0); QC_MM(qc3, 35);
#undef QC_OFF
#undef QC_MM
            }
#pragma unroll
            for (int vb = 0; vb < 9; ++vb) acc[vb] = acc[vb] * a0;
        }
#define MLW_PF(KS) ({ v4u pw; pw.x = pg8::cvt_pk_bf16(st[2 * KS][0], st[2 * KS][1]); pw.y = pg8::cvt_pk_bf16(st[2 * KS][2], st[2 * KS][3]); pw.z = pg8::cvt_pk_bf16(st[2 * KS + 1][0], st[2 * KS + 1][1]); pw.w = pg8::cvt_pk_bf16(st[2 * KS + 1][2], st[2 * KS + 1][3]); __builtin_bit_cast(bf16x8, pw); })
#define MLW_WAIT0() do { asm volatile("s_waitcnt lgkmcnt(0)" ::: "memory"); __builtin_amdgcn_sched_barrier(0); } while (0)
#define MLW_LOAD5(S, KS, BO) do { \
        S##a0 = trr<(32 * KS) * WVST + BO + 0>(vbase);  S##a1 = trr<(32 * KS + 16) * WVST + BO + 0>(vbase);  S##b0 = trr<(32 * KS) * WVST + BO + 32>(vbase); S##b1 = trr<(32 * KS + 16) * WVST + BO + 32>(vbase); \
        S##c0 = trr<(32 * KS) * WVST + BO + 64>(vbase); S##c1 = trr<(32 * KS + 16) * WVST + BO + 64>(vbase); S##d0 = trr<(32 * KS) * WVST + BO + 96>(vbase); S##d1 = trr<(32 * KS + 16) * WVST + BO + 96>(vbase); \
        S##o0 = trr<(32 * KS) * WVST + BO + 128>(vbase); S##o1 = trr<(32 * KS + 16) * WVST + BO + 128>(vbase); \
        S##k0 = trr<(32 * KS) * WKST>(kbase); S##k1 = trr<(32 * KS + 16) * WKST>(kbase); } while (0)
#define MLW_LOAD4(S, KS, BO) do { \
        S##a0 = trr<(32 * KS) * WVST + BO + 0>(vbase);  S##a1 = trr<(32 * KS + 16) * WVST + BO + 0>(vbase);  S##b0 = trr<(32 * KS) * WVST + BO + 32>(vbase); S##b1 = trr<(32 * KS + 16) * WVST + BO + 32>(vbase); \
        S##c0 = trr<(32 * KS) * WVST + BO + 64>(vbase); S##c1 = trr<(32 * KS + 16) * WVST + BO + 64>(vbase); S##d0 = trr<(32 * KS) * WVST + BO + 96>(vbase); S##d1 = trr<(32 * KS + 16) * WVST + BO + 96>(vbase); \
        S##k0 = trr<(32 * KS) * WKST>(kbase); S##k1 = trr<(32 * KS + 16) * WKST>(kbase); } while (0)
#define MLW_COMP(S, KS, NB, A0) do { \
        const bf16x8 v0 = ML_PK(S##a0, S##a1), v1 = ML_PK(S##b0, S##b1), v2 = ML_PK(S##c0, S##c1), v3 = ML_PK(S##d0, S##d1), v4 = ML_PK(S##o0, S##o1), kte = ML_PK(S##k0, S##k1); \
        if (lat && KS <= (rb >> 1)) { const bf16x8 pf = MLW_PF(KS); \
            acc[A0 + 0] = __builtin_amdgcn_mfma_f32_16x16x32_bf16(v0, pf, acc[A0 + 0], 0, 0, 0); acc[A0 + 1] = __builtin_amdgcn_mfma_f32_16x16x32_bf16(v1, pf, acc[A0 + 1], 0, 0, 0); \
            acc[A0 + 2] = __builtin_amdgcn_mfma_f32_16x16x32_bf16(v2, pf, acc[A0 + 2], 0, 0, 0); acc[A0 + 3] = __builtin_amdgcn_mfma_f32_16x16x32_bf16(v3, pf, acc[A0 + 3], 0, 0, 0); \
            if (NB == 5) acc[A0 + NB - 1] = __builtin_amdgcn_mfma_f32_16x16x32_bf16(v4, pf, acc[A0 + NB - 1], 0, 0, 0); } \
        dl[0] = __builtin_amdgcn_mfma_f32_16x16x32_bf16(kte, v0, dl[0], 0, 0, 0); dl[1] = __builtin_amdgcn_mfma_f32_16x16x32_bf16(kte, v1, dl[1], 0, 0, 0); \
        dl[2] = __builtin_amdgcn_mfma_f32_16x16x32_bf16(kte, v2, dl[2], 0, 0, 0); dl[3] = __builtin_amdgcn_mfma_f32_16x16x32_bf16(kte, v3, dl[3], 0, 0, 0); \
        if (NB == 5) dl[4] = __builtin_amdgcn_mfma_f32_16x16x32_bf16(kte, v4, dl[4], 0, 0, 0); } while (0)
        { s16x4 Aa0, Aa1, Ab0, Ab1, Ac0, Ac1, Ad0, Ad1, Ao0 = (s16x4){0, 0, 0, 0}, Ao1 = Ao0, Ak0, Ak1, Ba0, Ba1, Bb0, Bb1, Bc0, Bc1, Bd0, Bd1, Bo0 = Ao0, Bo1 = Ao0, Bk0, Bk1;
          f32x4 dl[5];
#pragma unroll
          for (int i = 0; i < 5; ++i) dl[i] = (f32x4){0.f, 0.f, 0.f, 0.f};
          MLW_LOAD5(A, 0, 0); MLW_LOAD5(B, 1, 0); MLW_WAITN(12); MLW_COMP(A, 0, 5, 0);
          asm volatile("" ::: "memory"); MLW_LOAD5(A, 2, 0); MLW_WAITN(12); MLW_COMP(B, 1, 5, 0);
          asm volatile("" ::: "memory"); MLW_LOAD5(B, 3, 0); MLW_WAITN(12); MLW_COMP(A, 2, 5, 0);
          asm volatile("" ::: "memory"); MLW_LOAD4(A, 0, 160); MLW_WAITN(10); MLW_COMP(B, 3, 5, 0);
#pragma unroll
          for (int vb = 0; vb < 5; ++vb) { Cst[vb] = Cst[vb] * a0 + dl[vb]; dl[vb] = (f32x4){0.f, 0.f, 0.f, 0.f}; }
          asm volatile("" ::: "memory"); MLW_LOAD4(B, 1, 160); MLW_WAITN(10); MLW_COMP(A, 0, 4, 5);
          asm volatile("" ::: "memory"); MLW_LOAD4(A, 2, 160); MLW_WAITN(10); MLW_COMP(B, 1, 4, 5);
          asm volatile("" ::: "memory"); MLW_LOAD4(B, 3, 160); MLW_WAITN(10); MLW_COMP(A, 2, 4, 5);
          MLW_WAITN(0); MLW_COMP(B, 3, 4, 5);
#pragma unroll
          for (int vb = 0; vb < 4; ++vb) Cst[5 + vb] = Cst[5 + vb] * a0 + dl[vb]; }
#undef MLW_LOAD5
#undef MLW_LOAD4
#undef MLW_COMP
#undef MLW_WAITN
#undef MLW_PF
#undef MLW_WAIT0
        if (lat) {
            const float em = AR[A_EM / 4 + prow];
            const float den = __shfl(acc[8][0], li);
            const float inv = 1.0f / fmaxf(fabsf(den), em);
            const size_t rb0 = (size_t)b * SEQ + 128 * ac;
#pragma unroll
            for (int hf = 0; hf < 2; ++hf) {
#pragma unroll
                for (int vb = 0; vb < 4; ++vb) { const f32x4 o = acc[4 * hf + vb] * inv; v2u wv; wv.x = pg8::cvt_pk_bf16(o[0], o[1]); wv.y = pg8::cvt_pk_bf16(o[2], o[3]);
                    *(LAS v2u*)(Pw + li * 144 + (16 * vb + 4 * q) * 2) = wv; }
                asm volatile("s_waitcnt lgkmcnt(0)" ::: "memory");
#pragma unroll
                for (int i = 0; i < 2; ++i) { const int idx = lane + 64 * i, row = idx >> 3, ch = idx & 7; const v4u ov = *(const LAS v4u*)(Pw + row * 144 + ch * 16);
                    const int p = 16 * rb + row; const int t = dir ? 127 - p : p; *(GAS v4u*)(Hd + (rb0 + t) * 2048 + h * 256 + vs * 128 + hf * 64 + 8 * ch) = ov; }
                asm volatile("s_waitcnt lgkmcnt(0)" ::: "memory");
            }
        }
        asm volatile("s_waitcnt lgkmcnt(0)" ::: "memory"); __builtin_amdgcn_s_barrier(); asm volatile("" ::: "memory");
        { const LAS float* AN = (const LAS float*)(lds + WAR_OFF + ((ci + 1) & 1) * AR_BUF);
#pragma unroll
          for (int i = 0; i < 4; ++i) en[i] = AN[A_E / 4 + ((tid + 512 * i) >> 4)]; }
#pragma unroll
        for (int vb = 0; vb < 9; ++vb) { v2u wv; wv.x = pg8::cvt_pk_bf16(Cst[vb][0], Cst[vb][1]); wv.y = pg8::cvt_pk_bf16(Cst[vb][2], Cst[vb][3]); *(LAS v2u*)(lds + WCT_OFF + (16 * vb + li) * WCST + (16 * w + 4 * q) * 2) = wv; }
    }
    __syncthreads();
#undef MLW_PREFETCH
#undef MLW_QFETCH
#undef MLW_ROWBASE
}
#undef ML_PK
}
__device__ __forceinline__ void phase_mem(Frame& F) {
    const int gw = F.bid * NWAVES + F.wave, NGW = F.G * NWAVES; const int lane = (int)(threadIdx.x & 63);
    f32x4 g[4][2];
#pragma unroll
    for (int j = 0; j < 4; ++j) { g[j][0] = *(const GAS f32x4*)(F.mlstm_norm_g + 8 * (64 * j + lane)); g[j][1] = *(const GAS f32x4*)(F.mlstm_norm_g + 8 * (64 * j + lane) + 4); }
    if (gw >= MLAT) return;
    v4u na[4], nc[4], nm[4];
    { const GAS v4u* p0 = (const GAS v4u*)(F.H0 + (size_t)gw * 2048) + lane; const GAS v4u* p1 = (const GAS v4u*)(F.H1 + (size_t)gw * 2048) + lane; const GAS v4u* pm = (const GAS v4u*)(F.AM + (size_t)gw * 4096 + 2048) + lane;
#pragma unroll
      for (int j = 0; j < 4; ++j) { na[j] = p0[64 * j]; nc[j] = p1[64 * j]; nm[j] = pm[64 * j]; } }
    for (int row = gw; row < MLAT; row += NGW) {
        v4u a[4], c[4], mo[4];
#pragma unroll
        for (int j = 0; j < 4; ++j) { a[j] = na[j]; c[j] = nc[j]; mo[j] = nm[j]; }
        if (row + NGW < MLAT) { const int rn = row + NGW; const GAS v4u* p0 = (const GAS v4u*)(F.H0 + (size_t)rn * 2048) + lane; const GAS v4u* p1 = (const GAS v4u*)(F.H1 + (size_t)rn * 2048) + lane; const GAS v4u* pm = (const GAS v4u*)(F.AM + (size_t)rn * 4096 + 2048) + lane;
#pragma unroll
            for (int j = 0; j < 4; ++j) { na[j] = p0[64 * j]; nc[j] = p1[64 * j]; nm[j] = pm[64 * j]; } }
        GAS v4u* po = (GAS v4u*)(F.AM + (size_t)row * 4096 + 2048) + lane;
#pragma unroll
        for (int j = 0; j < 4; ++j) { float hv[8]; float ss = 0.f;
#pragma unroll
            for (int e = 0; e < 4; ++e) { const float lo = bflo(a[j][e]) + bflo(c[j][e]), hi = bfhi(a[j][e]) + bfhi(c[j][e]); hv[2 * e] = lo; hv[2 * e + 1] = hi; ss += lo * lo + hi * hi; }
            const float hs = half_sums_dpp(ss);
            const float s_lo = __builtin_bit_cast(float, __builtin_amdgcn_readlane(__builtin_bit_cast(int, hs), 31)), s_hi = __builtin_bit_cast(float, __builtin_amdgcn_readlane(__builtin_bit_cast(int, hs), 63));
            const float r = __builtin_amdgcn_rsqf(((lane & 32) ? s_hi : s_lo) * (1.0f / 256.0f) + NORM_EPS);
            const float gg[8] = {g[j][0].x, g[j][0].y, g[j][0].z, g[j][0].w, g[j][1].x, g[j][1].y, g[j][1].z, g[j][1].w};
            v4u o;
#pragma unroll
            for (int e = 0; e < 4; ++e) { const float x0 = sigmoidf_(bflo(mo[j][e])) * hv[2 * e] * r * gg[2 * e], x1 = sigmoidf_(bfhi(mo[j][e])) * hv[2 * e + 1] * r * gg[2 * e + 1]; o[e] = pg8::cvt_pk_bf16(x0, x1); }
            po[64 * j] = o; }
    }
}
__device__ __forceinline__ void phase_final_norm(Frame& F) {
    const int gw = F.bid * NWAVES + F.wave, NGW = F.G * NWAVES; const int lane = (int)(threadIdx.x & 63);
    f32x4 g[4][2];
#pragma unroll
    for (int j = 0; j < 4; ++j) { g[j][0] = *(const GAS f32x4*)(F.final_norm_g + 8 * (64 * j + lane)); g[j][1] = *(const GAS f32x4*)(F.final_norm_g + 8 * (64 * j + lane) + 4); }
    if (gw >= MLAT) return;
    v4u nx[4];
    { const GAS v4u* xr = (const GAS v4u*)(F.H + (size_t)gw * D) + lane;
#pragma unroll
      for (int j = 0; j < 4; ++j) nx[j] = xr[64 * j]; }
    for (int row = gw; row < MLAT; row += NGW) {
        v4u cur[4];
#pragma unroll
        for (int j = 0; j < 4; ++j) cur[j] = nx[j];
        if (row + NGW < MLAT) { const GAS v4u* xr = (const GAS v4u*)(F.H + (size_t)(row + NGW) * D) + lane;
#pragma unroll
            for (int j = 0; j < 4; ++j) nx[j] = xr[64 * j]; }
        GAS f32x4* orow = (GAS f32x4*)(F.out + (size_t)row * D) + 2 * lane;
        f32x4 v[4][2]; float s = 0.f;
#pragma unroll
        for (int j = 0; j < 4; ++j) { const v4u w = cur[j]; v[j][0] = (f32x4){bflo(w.x), bfhi(w.x), bflo(w.y), bfhi(w.y)}; v[j][1] = (f32x4){bflo(w.z), bfhi(w.z), bflo(w.w), bfhi(w.w)};
            s += (v[j][0].x * v[j][0].x + v[j][0].y * v[j][0].y) + (v[j][0].z * v[j][0].z + v[j][0].w * v[j][0].w) + (v[j][1].x * v[j][1].x + v[j][1].y * v[j][1].y) + (v[j][1].z * v[j][1].z + v[j][1].w * v[j][1].w); }
        const float r = __builtin_amdgcn_rsqf(wave_sum_dpp(s) * (1.0f / D) + NORM_EPS);
#pragma unroll
        for (int j = 0; j < 4; ++j) { orow[128 * j] = (v[j][0] * r) * g[j][0]; orow[128 * j + 1] = (v[j][1] * r) * g[j][1]; }
    }
}

struct Args { const float* in[18]; float* out; unsigned char* ws; int ph_lo, ph_hi, li, pad; };
__global__ void __launch_bounds__(NWAVES * 64, 2) fwd_kernel(Args args) {
    extern __shared__ __attribute__((aligned(16))) unsigned char lds[];
    Frame F;
    F.lds = (LAS unsigned char*)lds;
    F.MISC = (volatile LAS unsigned*)(F.lds + MISC_OFF);
    F.wave = __builtin_amdgcn_readfirstlane((int)threadIdx.x >> 6);
    F.G = gridDim.x; F.bid = blockIdx.x;
    unsigned char* ws = args.ws;
    F.ctl = (gu32*)(ws + WS_CTL);
    F.x = args.in[0]; F.c = args.in[1]; F.ctx = args.in[2]; F.c_ctx = args.in[3]; F.w_ada = args.in[4]; F.b_ada = args.in[5]; F.norm1_g = args.in[6]; F.w_in = args.in[7]; F.b_gates = args.in[8];
    F.attn_sink = args.in[9]; F.mlstm_norm_g = args.in[10]; F.w_attn_proj = args.in[11]; F.w_mlstm_proj = args.in[12]; F.w_out = args.in[13]; F.norm2_g = args.in[14]; F.w_ffn_in = args.in[15];
    F.w_ffn_out = args.in[16]; F.final_norm_g = args.in[17]; F.out = args.out;
    F.MOD = (float*)(ws + WS_MOD); F.ROPE = (float*)(ws + WS_ROPE); F.MODP = (float*)(ws + WS_MODP); F.GATES = (float*)(ws + WS_GATES); F.GU = (float*)(ws + WS_GU); F.GB = (float*)(ws + WS_GB); F.GS = (float*)(ws + WS_GS);
    F.CKA = (bf16*)(ws + WS_CKA); F.CVA = (bf16*)(ws + WS_CVA); F.CMK = (bf16*)(ws + WS_CMK); F.CMV = (bf16*)(ws + WS_CMV);
    F.WAM = (bf16*)(ws + WS_WAM); F.WOUT = (bf16*)(ws + WS_WOUT); F.WFFI = (bf16*)(ws + WS_WFFI); F.WFFO = (bf16*)(ws + WS_WFFO); F.WIN = (bf16*)(ws + WS_WIN);
    F.H = (bf16*)(ws + WS_H); F.AM = (bf16*)(ws + WS_AM); F.KA = (bf16*)(ws + WS_KA); F.VA = (bf16*)(ws + WS_VA); F.MQ = (bf16*)(ws + WS_MQ); F.MK = (bf16*)(ws + WS_MK); F.MV = (bf16*)(ws + WS_MV);
    F.H0 = (bf16*)(ws + WS_H); F.H1 = (bf16*)(ws + WS_H1); F.Y = (bf16*)(ws + WS_Y); F.HDN = (bf16*)(ws + WS_HDN); F.GG = (bf16*)args.out;
    for (int u = (int)threadIdx.x; u < (LDS_BYTES - LDSCTL_OFF) / 4; u += NWAVES * 64) ((LAS unsigned*)(F.lds + LDSCTL_OFF))[u] = 0u;
    __syncthreads();
    XcdBarrier bar; bar.bar = (unsigned*)(F.ctl + CW_BAR); bar.x = 0; bar.st = nullptr;
    if (N_LAUNCHES == 1) bar = xcd_barrier_post((unsigned*)(F.ctl + CW_BAR), F.MISC + 8);
#define GRID_BAR(seam) do { if (N_LAUNCHES != 1) { if ((int)threadIdx.x == 0) __hip_atomic_store(F.ctl + CW_TMO, 0xBADBA0u | (unsigned)(seam), RLX_AGENT); } else { xcd_barrier(bar); } } while (0)
    const int lo = args.ph_lo, hi = args.ph_hi;
#define IN(k) (lo <= (k) && (k) < hi)
#define BOTH(k) (IN(k) && IN((k) + 1))
    const int gw = F.bid * NWAVES + F.wave, NGW = F.G * NWAVES;

    if (IN(0)) { phase_prologue(F, F.G == 256);
        if (BOTH(0)) GRID_BAR(0); }
    if (IN(1)) { phase_mod_reduce(F); if (BOTH(1)) GRID_BAR(1); }
    if (IN(2)) {
        constexpr int RPW = (MTOT + 2047) / 2048;
        const int rpw = (NGW >= 2048) ? RPW : (MTOT + NGW - 1) / NGW;
        const int r0 = gw * rpw, r1 = (r0 + rpw) < MTOT ? (r0 + rpw) : MTOT;
        norm_mod_rows(F, F.x, r0, r1, F.norm1_g, F.H, 0, 1, true);
        if (BOTH(2)) GRID_BAR(2);
    }
    if (IN(3)) {
        pg8::Gemm g{F.H, F.WIN, D, D, D}; pg8::OrderInProj S{F.G, F.bid};
        EpiInProj E{F.AM, F.KA, F.VA, F.MQ, F.MK, F.MV, F.GG, F.CKA, F.CVA, F.CMK, F.CMV, F.GATES, F.ROPE};
        pg8::gemm_phase<EpiInProj, pg8::OrderInProj, PG8_ALIGN, PG8_SP2, true>(F.lds + RING_OFF, g, S, E);
        if (BOTH(3)) GRID_BAR(3);
    }
    if (IN(4)) { phase_gate_scan(F); if (BOTH(4)) GRID_BAR(4); }
    if (IN(5)) {
        if (F.G == 256) {
            const int role = (F.bid >> 3) & 1, idx = (F.bid >> 4) * 8 + (F.bid & 7);
            if (role == 0) ml::mlstm_unit_wide(F, idx, lds);
            phase_attn_range(F, lds, idx * 16, role == 0 ? 0 : 10);
            convert_ffn_weights_queue(F);
        } else {
        for (int u0 = F.bid; u0 < 256; u0 += F.G) ml::mlstm_unit(F, u0, lds);
        __syncthreads();
        phase_attn_mfma<true>(F, lds);
        }
        if (BOTH(5)) GRID_BAR(5);
    }
    if (IN(6)) { phase_mem(F); if (BOTH(6)) GRID_BAR(6); }
    if (IN(7)) {
        pg8::Gemm g{F.AM, F.WAM, 4096, 4096, D}; pg8::OrderPair S{128, 8, F.G, F.bid, 2048 * 2};
        EpiMerge E{F.GG, F.Y};
        pg8::gemm_phase<EpiMerge, pg8::OrderPair, PG8_ALIGN, PG8_SP2>(F.lds + RING_OFF, g, S, E);
        if (BOTH(7)) GRID_BAR(7);
    }
    if (IN(8)) {
        pg8::Gemm g{F.Y, F.WOUT, D, D, D}; pg8::OrderPlain S{128, 8, F.G, F.bid};
        EpiResidBf16 E{F.x, (bf16*)F.out, F.MOD + 2 * D};
        pg8::gemm_phase<EpiResidBf16, pg8::OrderPlain, PG8_ALIGN, PG8_SP2, true>(F.lds + RING_OFF, g, S, E);
        if (BOTH(8)) GRID_BAR(8);
    }
    if (IN(9)) {
        const int rpw = (MLAT + NGW - 1) / NGW; const int r0 = gw * rpw, r1 = (r0 + rpw) < MLAT ? (r0 + rpw) : MLAT;
        norm_mod_rows_b(F, (const bf16*)F.out, r0, r1, F.norm2_g, F.H, 3, 4);
        if (BOTH(9)) GRID_BAR(9);
    }
    if (IN(10)) {
        pg8::Gemm g{F.H, F.WFFI, D, D, D}; pg8::OrderPlain S{128, 44, F.G, F.bid};
        EpiSwiGLU E{F.HDN};
        pg8::gemm_phase<EpiSwiGLU, pg8::OrderPlain, PG8_ALIGN, PG8_SP2, true>(F.lds + RING_OFF, g, S, E);
        if (BOTH(10)) GRID_BAR(10);
    }
    if (IN(11)) {
        pg8::Gemm g{F.HDN, F.WFFO, DFF, DFF, DFF}; pg8::OrderPlain S{128, 8, F.G, F.bid};
        EpiResidBB E{(const bf16*)F.out, F.H, F.MOD + 5 * D};
        pg8::gemm_phase<EpiResidBB, pg8::OrderPlain, PG8_ALIGN, PG8_SP2, true>(F.lds + RING_OFF, g, S, E);
        if (BOTH(11)) GRID_BAR(11);
    }
    if (IN(12)) { phase_final_norm(F); }
#undef IN
#undef BOTH
}

extern "C" void kernel_launch(void* const* d_in, const int* in_sizes, int n_in, void* d_out, int out_size, void* d_ws, size_t ws_size, hipStream_t stream) {
    static int grid = 0;
    if (grid == 0) {
        if (n_in != 18 || in_sizes[0] != MLAT * D || out_size != MLAT * D || ws_size < WS_END) { fprintf(stderr, "kernel_launch: unexpected shapes (n_in %d, in0 %d, out %d, ws %zu)\n", n_in, n_in > 0 ? in_sizes[0] : -1, out_size, ws_size); grid = -1; return; }
        int dev = 0, cus = 0, per_cu = 0;
        if (hipGetDevice(&dev) != hipSuccess || hipDeviceGetAttribute(&cus, hipDeviceAttributeMultiprocessorCount, dev) != hipSuccess) { grid = -1; return; }
        if (hipFuncSetAttribute((const void*)fwd_kernel, hipFuncAttributeMaxDynamicSharedMemorySize, LDS_BYTES) != hipSuccess) { fprintf(stderr, "kernel_launch: hipFuncSetAttribute failed\n"); grid = -1; return; }
        if (hipOccupancyMaxActiveBlocksPerMultiprocessor(&per_cu, (const void*)fwd_kernel, NWAVES * 64, LDS_BYTES) != hipSuccess || per_cu < 1)
            fprintf(stderr, "kernel_launch: note: occupancy query reports %d workgroups per CU\n", per_cu);
        (void)hipGetLastError();
        grid = cus;
    }
    if (grid < 0) return;
    if (hipMemsetAsync((char*)d_ws + WS_CTL, 0, CTL_ZERO_BYTES, stream) != hipSuccess) return;
    Args a{};
    for (int i = 0; i < 18; ++i) a.in[i] = (const float*)d_in[i];
    a.out = (float*)d_out; a.ws = (unsigned char*)d_ws;
    for (int li = 0; li < N_LAUNCHES; ++li) {
        a.ph_lo = (N_LAUNCHES == 1) ? 0 : li; a.ph_hi = (N_LAUNCHES == 1) ? N_PHASES : li + 1; a.li = li; a.pad = 0;
        hipLaunchKernelGGL(fwd_kernel, dim3(grid), dim3(NWAVES * 64), LDS_BYTES, stream, a);
        if (hipPeekAtLastError() != hipSuccess) { fprintf(stderr, "kernel_launch: launch %d failed\n", li); break; }
    }
}
```

```cpp
#include <hip/hip_runtime.h>
#include <cstdio>
#include <cstdint>

#ifndef MK_N_LAUNCHES
#define MK_N_LAUNCHES 1
#endif

namespace pg8 {
#define PG8_LAS __attribute__((address_space(3)))
typedef unsigned short bf16_t;
typedef short bf16x8 __attribute__((ext_vector_type(8)));
typedef float f32x4 __attribute__((ext_vector_type(4)));
typedef unsigned u32x4 __attribute__((ext_vector_type(4)));
constexpr int BM = 256, BK = 64, HALF = 128, HTB = HALF * BK * 2  , STAGE_BYTES = 8 * HTB, NXCD = 8, WGM = 4;

__host__ __device__ __forceinline__ int lds_byte(int r, int c) { const int st = (r >> 4) * 2 + (c >> 5), rr = r & 15, cc = c & 31, ob = rr * 64 + cc * 2; return st * 1024 + (ob ^ (((ob >> 9) & 1) << 5)); }
__host__ __device__ __forceinline__ void stage_rc(int b, int& R, int& C) { const int st = b / 1024, sb = b % 1024, swz = sb ^ (((sb >> 9) & 1) << 5); R = (st >> 1) * 16 + swz / 64; C = (st & 1) * 32 + (swz % 64) / 2; }
__host__ __device__ __forceinline__ int perm32(int rho) { const int n = rho >> 4, i = rho & 15; return 8 * (i >> 2) + 4 * n + (i & 3); }

struct Unit { int pm, pn, ka, kb, flag; };
struct Gemm { const bf16_t* A; const bf16_t* Bt; int lda, ldb, K; };

__device__ __forceinline__ void tile_map(int L, int nM, int nN, int& pm, int& pn) {
    const int nwg = nM * nN; int wgid = L; { const int q = nwg / NXCD, r = nwg % NXCD, xcd = wgid % NXCD, off = wgid / NXCD; wgid = (xcd < r ? xcd * (q + 1) : r * (q + 1) + (xcd - r) * q) + off; }
    const int nig = WGM * nN, gid = wgid / nig, fm = gid * WGM, gsz = (nM % WGM == 0) ? WGM : ((nM - fm) < WGM ? (nM - fm) : WGM);
    pm = fm + ((wgid % nig) % gsz); pn = (wgid % nig) / gsz;
}
struct OrderPlain {
    int nM, nN, G, c;
    __device__ __forceinline__ bool next(int i, Unit& u) const { const long L = (long)i * G + c; if (L >= (long)nM * nN) return false; tile_map((int)L, nM, nN, u.pm, u.pn); u.ka = 0; u.kb = 0; u.flag = 0; return true; }
    __device__ __forceinline__ void a_ready(const Unit&) const {}
    __device__ __forceinline__ void done(const Unit&) const {}
};
struct OrderPair {
    int nM, nN, G, c, khalf_bytes;
    __device__ __forceinline__ bool next(int i, Unit& u) const { const long L = (long)(i >> 1) * G + c; if (L >= (long)nM * nN) return false; tile_map((int)L, nM, nN, u.pm, u.pn); u.flag = i & 1; u.ka = u.kb = (i & 1) * khalf_bytes; return true; }
    __device__ __forceinline__ void a_ready(const Unit&) const {}
    __device__ __forceinline__ void done(const Unit&) const {}
};
struct OrderInProj {
    int G, c;
    __device__ __forceinline__ bool next(int i, Unit& u) const {
        const long L = (long)i * G + c; u.ka = 0; u.kb = 0; u.flag = 0;
        if (L < 128 * 53) { tile_map((int)L, 128, 53, u.pm, u.pn); return true; }
        const int r = (int)(L - 128 * 53); if (r >= 4 * 17) return false;
        u.pm = 128 + r / 17; const int j = r % 17; u.pn = j < 16 ? j : 52; return true;
    }
    __device__ __forceinline__ void a_ready(const Unit&) const {}
    __device__ __forceinline__ void done(const Unit&) const {}
};

__device__ __forceinline__ unsigned cvt_pk_bf16(float lo, float hi) { unsigned r; asm volatile("v_cvt_pk_bf16_f32 %0, %1, %2" : "=v"(r) : "v"(lo), "v"(hi)); return r; }

template <class Epi, class Sched, bool ALIGN_EPI = false, bool SP2 = false, bool ATILED = false>
__device__ __forceinline__ void gemm_phase(PG8_LAS unsigned char* lds, const Gemm g, const Sched& S, const Epi& E) {
    const int tid = threadIdx.x, wid = __builtin_amdgcn_readfirstlane(tid >> 6), lane = tid & 63, wr = wid >> 2, wc = wid & 3, fr = lane & 15, fq = lane >> 4;
    const int K = g.K, nt = K / BK;
    unsigned voffA[2], voffB[2];
#pragma unroll
    for (int i = 0; i < 2; ++i) { int R, C; stage_rc(tid * 16 + i * 8192, R, C); const int Rb = Epi::PERM ? ((R & ~31) + perm32(R & 31)) : R;
        voffA[i] = ATILED ? (unsigned)(R * BK + C) * 2u : (unsigned)(R * g.lda + C) * 2u; voffB[i] = (unsigned)(tid * 16 + i * 8192); (void)Rb; }
    const size_t kstep = ATILED ? (size_t)BM * BK * 2 : (size_t)(BK * 2);
    const size_t kstepB = (size_t)BM * BK * 2;
    const size_t hstepA = ATILED ? (size_t)HALF * BK * 2 : (size_t)HALF * g.lda * 2, hstepB = (size_t)HALF * BK * 2;
    const size_t tstepA = (size_t)BM * g.lda * 2, tstepB = (size_t)BM * g.ldb * 2;
    const unsigned ldsw = (unsigned)wid * 1024u;
    const int aoff = lds_byte(wr * 64 + fr, fq * 8), boff = lds_byte(wc * 32 + fr, fq * 8);
#define PG8_SA(b, h) (((b) * 2 + (h)) * HTB)
#define PG8_SB(b, h) ((4 + (b) * 2 + (h)) * HTB)
#define PG8_STAGE(bufoff, gbase, voff) do { _Pragma("unroll") for (int _i = 0; _i < 2; ++_i) \
        __builtin_amdgcn_global_load_lds((const unsigned*)((const char*)(gbase) + (voff)[_i]), (PG8_LAS unsigned*)(lds + (bufoff) + ldsw + _i * 8192), 16, 0, 0); } while (0)
#define PG8_LDA(dst, b, h) do { _Pragma("unroll") for (int m = 0; m < 4; ++m) _Pragma("unroll") for (int k = 0; k < 2; ++k) dst[m][k] = *(const PG8_LAS bf16x8*)(lds + PG8_SA(b, h) + aoff + m * 2048 + k * 1024); } while (0)
#define PG8_LDB(dst, b, h) do { _Pragma("unroll") for (int n = 0; n < 2; ++n) _Pragma("unroll") for (int k = 0; k < 2; ++k) dst[n][k] = *(const PG8_LAS bf16x8*)(lds + PG8_SB(b, h) + boff + n * 2048 + k * 1024); } while (0)
#define PG8_MMA(ai, bj, At, Bt) do { __builtin_amdgcn_s_setprio(1); _Pragma("unroll") for (int m = 0; m < 4; ++m) _Pragma("unroll") for (int n = 0; n < 2; ++n) { _Pragma("unroll") for (int k = 0; k < 2; ++k) \
        acc[ai][bj][m][n] = __builtin_amdgcn_mfma_f32_16x16x32_bf16(Bt[n][k], At[m][k], acc[ai][bj][m][n], 0, 0, 0); __builtin_amdgcn_sched_barrier(0); } __builtin_amdgcn_s_setprio(0); } while (0)
#define PG8_WAIT_V(n) asm volatile("s_waitcnt vmcnt(" #n ")" ::: "memory")
#define PG8_WAIT_L(n) asm volatile("s_waitcnt lgkmcnt(" #n ")" ::: "memory")
#define PG8_BAR __builtin_amdgcn_s_barrier()
#define PG8_SCHED __builtin_amdgcn_sched_barrier(0)
    Unit cur, nxt; int ui = 0;
    if (!S.next(0, cur)) return;
    f32x4 acc[2][2][4][2];
#pragma unroll
    for (int a = 0; a < 2; ++a)
#pragma unroll
        for (int b = 0; b < 2; ++b)
#pragma unroll
            for (int m = 0; m < 4; ++m)
#pragma unroll
                for (int n = 0; n < 2; ++n) acc[a][b][m][n] = (f32x4){0.f, 0.f, 0.f, 0.f};
    bf16x8 At[4][2], B0[2][2], B1[2][2];
    const char* cA = (const char*)g.A + (size_t)cur.pm * tstepA + cur.ka; const char* cB = (const char*)g.Bt + (size_t)cur.pn * tstepB + (size_t)(cur.kb >> 7) * kstepB;
    S.a_ready(cur);
    if constexpr (SP2) {
        PG8_STAGE(PG8_SB(0, 0), cB, voffB); PG8_STAGE(PG8_SB(0, 1), cB + hstepB, voffB); PG8_STAGE(PG8_SA(0, 0), cA, voffA); PG8_STAGE(PG8_SA(0, 1), cA + hstepA, voffA);
        if (wr == 1) PG8_BAR;
        PG8_WAIT_V(2); PG8_BAR;
        PG8_STAGE(PG8_SB(1, 0), cB + kstepB, voffB); PG8_STAGE(PG8_SA(1, 0), cA + kstep, voffA); PG8_STAGE(PG8_SB(1, 1), cB + hstepB + kstepB, voffB);
        PG8_WAIT_V(6); PG8_BAR;
    } else {
        PG8_STAGE(PG8_SB(0, 0), cB, voffB); PG8_STAGE(PG8_SA(0, 0), cA, voffA); PG8_STAGE(PG8_SB(0, 1), cB + hstepB, voffB); PG8_STAGE(PG8_SA(0, 1), cA + hstepA, voffA);
        if (wr == 1) PG8_BAR;
        PG8_WAIT_V(4); PG8_BAR;
        PG8_STAGE(PG8_SB(1, 0), cB + kstepB, voffB); PG8_STAGE(PG8_SA(1, 0), cA + kstep, voffA); PG8_STAGE(PG8_SB(1, 1), cB + hstepB + kstepB, voffB);
        PG8_WAIT_V(6); PG8_BAR;
    }
    for (;;) {
        const bool has_next = S.next(ui + 1, nxt);
        const char* nA = has_next ? (const char*)g.A + (size_t)nxt.pm * tstepA + nxt.ka : cA; const char* nB = has_next ? (const char*)g.Bt + (size_t)nxt.pn * tstepB + (size_t)(nxt.kb >> 7) * kstepB : cB;
        for (int t = 0; t < nt; t += 2) {
            const bool last = (t == nt - 2);
            const char* a1 = cA + (size_t)(t + 1) * kstep;
            const char* a2 = last ? nA : cA + (size_t)(t + 2) * kstep; const char* b2 = last ? nB : cB + (size_t)(t + 2) * kstepB;
            const char* a3 = a2 + kstep; const char* b3 = b2 + kstepB;
            if (last && has_next) S.a_ready(nxt);
            if constexpr (SP2) {
            PG8_LDB(B0, 0, 0); PG8_LDB(B1, 0, 1); PG8_SCHED; PG8_LDA(At, 0, 0); PG8_STAGE(PG8_SA(1, 1), a1 + hstepA, voffA);
            PG8_WAIT_V(8); PG8_WAIT_L(0); PG8_BAR; PG8_MMA(0, 0, At, B0); PG8_MMA(0, 1, At, B1); PG8_BAR; PG8_SCHED;
            PG8_LDA(At, 0, 1); PG8_STAGE(PG8_SB(0, 0), b2, voffB); PG8_STAGE(PG8_SB(0, 1), b2 + hstepB, voffB); PG8_STAGE(PG8_SA(0, 0), a2, voffA);
            PG8_WAIT_V(8); PG8_WAIT_L(0); PG8_BAR; PG8_MMA(1, 0, At, B0); PG8_MMA(1, 1, At, B1); PG8_BAR; PG8_SCHED;
            PG8_LDB(B0, 1, 0); PG8_LDB(B1, 1, 1); PG8_SCHED; PG8_LDA(At, 1, 0); PG8_STAGE(PG8_SA(0, 1), a2 + hstepA, voffA);
            PG8_WAIT_V(8); PG8_WAIT_L(0); PG8_BAR; PG8_MMA(0, 0, At, B0); PG8_MMA(0, 1, At, B1); PG8_BAR; PG8_SCHED;
            PG8_LDA(At, 1, 1); PG8_STAGE(PG8_SB(1, 0), b3, voffB); PG8_STAGE(PG8_SB(1, 1), b3 + hstepB, voffB); PG8_STAGE(PG8_SA(1, 0), a3, voffA);
            PG8_WAIT_V(8); PG8_WAIT_L(0); PG8_BAR; PG8_MMA(1, 0, At, B0); PG8_MMA(1, 1, At, B1); PG8_BAR; PG8_SCHED;
            } else {
            PG8_LDB(B0, 0, 0); PG8_SCHED; PG8_LDA(At, 0, 0); PG8_STAGE(PG8_SA(1, 1), a1 + hstepA, voffA);
            PG8_WAIT_L(8); PG8_BAR; PG8_WAIT_L(0); PG8_MMA(0, 0, At, B0); PG8_BAR; PG8_SCHED;
            PG8_LDB(B1, 0, 1); PG8_STAGE(PG8_SB(0, 0), b2, voffB);
            PG8_BAR; PG8_WAIT_L(0); PG8_MMA(0, 1, At, B1); PG8_BAR;
            PG8_LDA(At, 0, 1); PG8_STAGE(PG8_SA(0, 0), a2, voffA);
            PG8_BAR; PG8_WAIT_L(0); PG8_MMA(1, 0, At, B0); PG8_BAR; PG8_SCHED;
            PG8_STAGE(PG8_SB(0, 1), b2 + hstepB, voffB);
            PG8_WAIT_V(6); PG8_BAR; PG8_MMA(1, 1, At, B1); PG8_BAR;
            PG8_LDB(B0, 1, 0); PG8_SCHED; PG8_LDA(At, 1, 0); PG8_STAGE(PG8_SA(0, 1), a2 + hstepA, voffA);
            PG8_WAIT_L(8); PG8_BAR; PG8_WAIT_L(0); PG8_MMA(0, 0, At, B0); PG8_BAR; PG8_SCHED;
            PG8_LDB(B1, 1, 1); PG8_STAGE(PG8_SB(1, 0), b3, voffB);
            PG8_BAR; PG8_WAIT_L(0); PG8_MMA(0, 1, At, B1); PG8_BAR;
            PG8_LDA(At, 1, 1); PG8_STAGE(PG8_SA(1, 0), a3, voffA);
            PG8_BAR; PG8_WAIT_L(0); PG8_MMA(1, 0, At, B0); PG8_BAR; PG8_SCHED;
            PG8_STAGE(PG8_SB(1, 1), b3 + hstepB, voffB);
            PG8_WAIT_V(6); PG8_BAR; PG8_MMA(1, 1, At, B1); PG8_BAR;
            }
        }
        if constexpr (ALIGN_EPI) { if (wr == 0) PG8_BAR; }
        E(acc, cur, wr, wc, fr, fq); S.done(cur);
        if (!has_next) break;
        if (!E.keep(cur)) {
#pragma unroll
        for (int a = 0; a < 2; ++a)
#pragma unroll
            for (int b = 0; b < 2; ++b)
#pragma unroll
                for (int m = 0; m < 4; ++m)
#pragma unroll
                    for (int n = 0; n < 2; ++n) acc[a][b][m][n] = (f32x4){0.f, 0.f, 0.f, 0.f};
        }
        cur = nxt; cA = nA; cB = nB; ++ui;
        if constexpr (ALIGN_EPI) { if (wr == 1) PG8_BAR; }
    }
    PG8_WAIT_V(0);
    if constexpr (!ALIGN_EPI) { if (wr == 0) PG8_BAR; }
    PG8_BAR;
#undef PG8_SA
#undef PG8_SB
#undef PG8_STAGE
#undef PG8_LDA
#undef PG8_LDB
#undef PG8_MMA
#undef PG8_WAIT_V
#undef PG8_WAIT_L
#undef PG8_BAR
#undef PG8_SCHED
}
}

#ifndef PG8_SP2
#define PG8_SP2 true
#endif
#ifndef PG8_ALIGN
#define PG8_ALIGN true
#endif

constexpr int NWAVES = 8;
constexpr int N_LAUNCHES = MK_N_LAUNCHES;
constexpr int N_PHASES = 13;
constexpr int D = 2048, NB = 4, SEQ = 8192, CL = 256, MLAT = NB * SEQ, MCTX = NB * CL, MTOT = MLAT + MCTX;
constexpr int DFF = 5632, NMOD = 6 * D;
constexpr int W_IN_COLS = 13344;
constexpr int NIN_T = 53 * 256;
constexpr float NORM_EPS = 1e-6f;
constexpr float QSCALE = 0.08838834764831845f;

constexpr size_t MiB = 1u << 20;
constexpr size_t WS_CTL = 0, CTL_ZERO_BYTES = 1 * MiB;
constexpr size_t WS_MOD = 1 * MiB;
constexpr size_t WS_ROPE = 1 * MiB + 512 * 1024;
constexpr size_t WS_MODP = 2 * MiB;
constexpr size_t WS_GU = 2 * MiB, WS_GB = 5 * MiB, WS_GS = 8 * MiB;
constexpr size_t WS_GATES = 10 * MiB;
constexpr size_t WS_CKA = 16 * MiB, WS_CVA = 17 * MiB, WS_CMK = 18 * MiB, WS_CMV = 20 * MiB;
constexpr size_t WS_WAM = 24 * MiB;
constexpr size_t WS_WOUT = 40 * MiB;
constexpr size_t WS_WFFI = 48 * MiB;
constexpr size_t WS_WFFO = 92 * MiB;
constexpr size_t WS_WIN = 114 * MiB;
constexpr size_t WS_H = 168 * MiB;
constexpr size_t WS_AM = 300 * MiB;
constexpr size_t WS_KA = 556 * MiB, WS_VA = 588 * MiB;
constexpr size_t WS_MQ = 620 * MiB, WS_MK = 684 * MiB;
constexpr size_t WS_MV = 748 * MiB;
constexpr size_t WS_H1 = 876 * MiB;
constexpr size_t WS_Y = 556 * MiB;
constexpr size_t WS_HDN = 300 * MiB;
constexpr size_t WS_END = 1004 * MiB;
constexpr int CW_TMO = 0, CW_CODE = 1, CW_QUEUE = 64, CW_AQUEUE = 96;
constexpr int CW_BAR = 4096;

constexpr int RING_OFF = 0, RING_BYTES = 131072;
constexpr int LDSCTL_OFF = RING_BYTES, MISC_OFF = LDSCTL_OFF + 320;
constexpr int LDS_BYTES = 147456;

#define GAS __attribute__((address_space(1)))
#define LAS __attribute__((address_space(3)))
typedef unsigned short bf16;
typedef unsigned v4u __attribute__((ext_vector_type(4)));
typedef unsigned v2u __attribute__((ext_vector_type(2)));
typedef float f32x4 __attribute__((ext_vector_type(4)));
typedef GAS unsigned gu32;
#define RLX_AGENT __ATOMIC_RELAXED, __HIP_MEMORY_SCOPE_AGENT
#define LDS_WAIT() asm volatile("s_waitcnt lgkmcnt(0)" ::: "memory")
#define VM_WAIT() asm volatile("s_waitcnt vmcnt(0)" ::: "memory")
__device__ __forceinline__ unsigned f2bf(float f) { unsigned u = __builtin_bit_cast(unsigned, f); return (u + 0x7fffu + ((u >> 16) & 1u)) >> 16; }
__device__ __forceinline__ unsigned pk2(float lo, float hi) { return f2bf(lo) | (f2bf(hi) << 16); }
__device__ __forceinline__ float bflo(unsigned w) { return __builtin_bit_cast(float, w << 16); }
__device__ __forceinline__ float bfhi(unsigned w) { return __builtin_bit_cast(float, w & 0xffff0000u); }
__device__ __forceinline__ float bf2f(bf16 h) { return __builtin_bit_cast(float, (unsigned)h << 16); }
__device__ __forceinline__ float wave_sum(float v) {
#pragma unroll
    for (int o = 1; o < 64; o <<= 1) v += __shfl_xor(v, o);
    return v;
}
template <int CTRL, int ROWMASK> __device__ __forceinline__ float dpp_add(float v) { return v + __builtin_bit_cast(float, __builtin_amdgcn_update_dpp(0, __builtin_bit_cast(int, v), CTRL, ROWMASK, 0xf, true)); }
__device__ __forceinline__ float half_sums_dpp(float v) {
    v = dpp_add<0x111, 0xf>(v); v = dpp_add<0x112, 0xf>(v); v = dpp_add<0x114, 0xf>(v); v = dpp_add<0x118, 0xf>(v);
    return v + __builtin_bit_cast(float, __builtin_amdgcn_update_dpp(0, __builtin_bit_cast(int, v), 0x142, 0xa, 0xf, false));
}
__device__ __forceinline__ float wave_sum_dpp(float v) {
    v = half_sums_dpp(v);
    return __builtin_bit_cast(float, __builtin_amdgcn_readlane(__builtin_bit_cast(int, v), 31)) + __builtin_bit_cast(float, __builtin_amdgcn_readlane(__builtin_bit_cast(int, v), 63));
}
__device__ __forceinline__ float wave_max(float v) {
#pragma unroll
    for (int o = 1; o < 64; o <<= 1) v = fmaxf(v, __shfl_xor(v, o));
    return v;
}
__device__ __forceinline__ float frcp(float x) { return __builtin_amdgcn_rcpf(x); }
__device__ __forceinline__ float sigmoidf_(float x) { return frcp(1.0f + __expf(-x)); }

#define XB_TMO      128
#define XB_XCNT(j)  (256  + 64 * (j))
#define XB_XSUB(j)  (1280 + 64 * (j))
#define XB_XGEN(j)  (2304 + 64 * (j))
#define XB_TOP      3328
#define XB_TOPGEN   3392
#define XCD_BAR_WORDS 3456
#define XB_SPIN_CAP (1u << 18)

__device__ __forceinline__ unsigned xb_ld(unsigned* p)              { return __hip_atomic_load(p, __ATOMIC_RELAXED, __HIP_MEMORY_SCOPE_AGENT); }
__device__ __forceinline__ unsigned xb_add(unsigned* p, unsigned v) { return __hip_atomic_fetch_add(p, v, __ATOMIC_RELAXED, __HIP_MEMORY_SCOPE_AGENT); }
__device__ __forceinline__ unsigned xb_xcc_id() { return (unsigned)__builtin_amdgcn_s_getreg((3 << 11) | 20) & 0xFu; }
#define XB_SPIN(cond, bar) do { unsigned _sp = 0; while (cond) { __builtin_amdgcn_s_sleep(1); \
    if ((++_sp & 255u) == 0u) { if (xb_ld(&(bar)[XB_TMO])) break; if (_sp > XB_SPIN_CAP) { atomicAdd(&(bar)[XB_TMO], 1u); break; } } } } while (0)

struct XcdBarrier {
    unsigned* bar; unsigned x;
    volatile LAS unsigned* st;
};
__device__ __forceinline__ XcdBarrier xcd_barrier_post(unsigned* bar, volatile LAS unsigned* st) {
    XcdBarrier b; b.bar = bar; b.x = xb_xcc_id(); b.st = st;
    if (threadIdx.x == 0) (void)xb_add(&bar[XB_XCNT(b.x)], 1u);
    return b;
}
__device__ __forceinline__ void xcd_barrier_complete(unsigned* bar, unsigned x, unsigned& nloc, unsigned& nx) {
    const unsigned G = gridDim.x * gridDim.y * gridDim.z;
    unsigned sum, cnt, mine, sp = 0u;
    for (;;) {
        sum = 0u; cnt = 0u; mine = 0u;
#pragma unroll
        for (unsigned j = 0; j < 16; ++j) { const unsigned c = xb_ld(&bar[XB_XCNT(j)]); sum += c; cnt += (c > 0u) ? 1u : 0u; mine = (j == x) ? c : mine; }
        if (sum == G) break;
        __builtin_amdgcn_s_sleep(1);
        if ((++sp & 255u) == 0u) { if (xb_ld(&bar[XB_TMO])) break; if (sp > XB_SPIN_CAP) { atomicAdd(&bar[XB_TMO], 1u); break; } }
    }
    nloc = mine > 0u ? mine : 1u; nx = cnt > 0u ? cnt : 1u;
}
__device__ __forceinline__ void xcd_barrier(const XcdBarrier& b) {
    asm volatile("s_waitcnt vmcnt(0)" ::: "memory");
    __syncthreads();
    if (threadIdx.x == 0) {
        unsigned* bar = b.bar;
        __builtin_amdgcn_s_waitcnt(0);
        unsigned nloc = b.st[0], nx = b.st[1];
        if (nloc == 0u) { xcd_barrier_complete(bar, b.x, nloc, nx); b.st[0] = nloc; b.st[1] = nx; }
        const unsigned old = xb_add(&bar[XB_XSUB(b.x)], 1u);
        const unsigned gen = old / nloc;
        if (old + 1u == (gen + 1u) * nloc) {
            __builtin_amdgcn_fence(__ATOMIC_RELEASE, "agent");
            asm volatile("s_waitcnt vmcnt(0)" ::: "memory");
            const unsigned og = xb_add(&bar[XB_TOP], 1u);
            const unsigned tg = og / nx;
            if (og + 1u == (tg + 1u) * nx) xb_add(&bar[XB_TOPGEN], 1u);
            else XB_SPIN(xb_ld(&bar[XB_TOPGEN]) == tg, bar);
            __builtin_amdgcn_fence(__ATOMIC_ACQUIRE, "agent");
            xb_add(&bar[XB_XGEN(b.x)], 1u);
            asm volatile("s_waitcnt vmcnt(0)" ::: "memory");
        } else {
            XB_SPIN(xb_ld(&bar[XB_XGEN(b.x)]) == gen, bar);
            __builtin_amdgcn_fence(__ATOMIC_ACQUIRE, "agent");
            asm volatile("s_waitcnt vmcnt(0)" ::: "memory");
        }
    }
    __syncthreads();
}

struct Frame {
    LAS unsigned char* lds;
    volatile LAS unsigned* MISC;
    gu32* ctl;
    int wave, G, bid;
    const float *x, *c, *ctx, *c_ctx, *w_ada, *b_ada, *norm1_g, *w_in, *b_gates, *attn_sink, *mlstm_norm_g, *w_attn_proj, *w_mlstm_proj, *w_out, *norm2_g, *w_ffn_in, *w_ffn_out, *final_norm_g;
    float* out;
    float *MOD, *ROPE, *MODP, *GATES, *GU, *GB, *GS;
    bf16 *CKA, *CVA, *CMK, *CMV, *WAM, *WOUT, *WFFI, *WFFO, *WIN, *H, *AM, *KA, *VA, *MQ, *MK, *MV, *H0, *H1, *Y, *HDN, *GG;
};

__device__ __forceinline__ pg8::u32x4 lane_t(pg8::u32x4 w, int srcb) { pg8::u32x4 r; r.x = (unsigned)__builtin_amdgcn_ds_bpermute(srcb, (int)w.x); r.y = (unsigned)__builtin_amdgcn_ds_bpermute(srcb, (int)w.y); r.z = (unsigned)__builtin_amdgcn_ds_bpermute(srcb, (int)w.z); r.w = (unsigned)__builtin_amdgcn_ds_bpermute(srcb, (int)w.w); return r; }
#define LANE_T_SETUP const int lt_l = fr + 16 * fq, rr = lt_l >> 2, cq = lt_l & 3, srcb = 4 * (rr + 16 * cq);
struct EpiInProj {
    static constexpr bool PERM = true;
    bf16 *AM, *KA, *VA, *MQ, *MK, *MV, *GG, *CKA, *CVA, *CMK, *CMV; float* GATES; const float* ROPE;
    __device__ __forceinline__ bool keep(const pg8::Unit&) const { return false; }
    __device__ __forceinline__ void operator()(pg8::f32x4 (&acc)[2][2][4][2], const pg8::Unit& u, int wr, int wc, int fr, int fq) const {
        const int pn = u.pn; const int row0 = u.pm * 256 + wr * 64 + fr; LANE_T_SETUP
        if (pn == 52) {
            if (wc == 0) {
#pragma unroll
                for (int ai = 0; ai < 2; ++ai)
#pragma unroll
                    for (int m = 0; m < 4; ++m) { float* gp = GATES + (size_t)(row0 + ai * 128 + m * 16) * 32 + 8 * fq; *(pg8::f32x4*)gp = acc[ai][0][m][0]; *(pg8::f32x4*)(gp + 4) = acc[ai][0][m][1]; }
            }
            return;
        }
        bf16* base; int ldc, coff; int rsub = 0;
        if (u.pm < 128) {
            if (pn < 2)       { base = KA; ldc = 512;  coff = pn * 256; }
            else if (pn < 4)  { base = VA; ldc = 512;  coff = (pn - 2) * 256; }
            else if (pn < 8)  { base = MK; ldc = 1024; coff = (pn - 4) * 256; }
            else if (pn < 16) { base = MV; ldc = 2048; coff = (pn - 8) * 256; }
            else if (pn < 24) { base = AM; ldc = 4096; coff = (pn - 16) * 256; }
            else if (pn < 28) { base = MQ; ldc = 1024; coff = (pn - 24) * 256; }
            else if (pn < 36) { base = AM; ldc = 4096; coff = 2048 + (pn - 28) * 256; }
            else              { base = GG; ldc = 4096; coff = (pn - 36) * 256; }
        } else {
            rsub = MLAT;
            if (pn < 2)       { base = CKA; ldc = 512;  coff = pn * 256; }
            else if (pn < 4)  { base = CVA; ldc = 512;  coff = (pn - 2) * 256; }
            else if (pn < 8)  { base = CMK; ldc = 1024; coff = (pn - 4) * 256; }
            else              { base = CMV; ldc = 2048; coff = (pn - 8) * 256; }
        }
        if (pn < 2 || (pn >= 16 && pn < 24)) {
            const int half = wc >> 1, i0 = 16 * (wc & 1) + 4 * fq; const bool rot = u.pm < 128;
            pg8::f32x4 csr[2][4], snr[2][4];
#pragma unroll
            for (int ai = 0; ai < 2; ++ai)
#pragma unroll
                for (int m = 0; m < 4; ++m) { const int row = row0 - rsub + ai * 128 + m * 16; const int t = row & (SEQ - 1); const int pos = half ? (t & 63) : (t >> 6);
                    csr[ai][m] = (pg8::f32x4){1.f, 1.f, 1.f, 1.f}; snr[ai][m] = (pg8::f32x4){0.f, 0.f, 0.f, 0.f};
                    if (rot) { csr[ai][m] = *(const pg8::f32x4*)(ROPE + pos * 32 + i0); snr[ai][m] = *(const pg8::f32x4*)(ROPE + 4096 + pos * 32 + i0); } }
#pragma unroll
            for (int ai = 0; ai < 2; ++ai)
#pragma unroll
                for (int m = 0; m < 4; ++m) { const int row = row0 - rsub + ai * 128 + m * 16; const pg8::f32x4 cs = csr[ai][m], sn = snr[ai][m];
                    bf16* rowp = base + (size_t)(row - fr + rr) * ldc + coff + wc * 32 + 8 * cq;
                    pg8::u32x4 w[2];
#pragma unroll
                    for (int bj = 0; bj < 2; ++bj) { const pg8::f32x4 x1 = acc[ai][bj][m][0], x2 = acc[ai][bj][m][1]; const pg8::f32x4 o1 = x1 * cs - x2 * sn, o2 = x2 * cs + x1 * sn;
                        w[bj].x = pg8::cvt_pk_bf16(o1[0], o1[1]); w[bj].y = pg8::cvt_pk_bf16(o1[2], o1[3]); w[bj].z = pg8::cvt_pk_bf16(o2[0], o2[1]); w[bj].w = pg8::cvt_pk_bf16(o2[2], o2[3]); }
                    const pg8::u32x4 t0 = lane_t(w[0], srcb), t1 = lane_t(w[1], srcb);
                    *(pg8::u32x4*)rowp = t0; *(pg8::u32x4*)(rowp + 128) = t1; }
            return;
        }
        const int col0 = coff + wc * 32 + 8 * cq; bf16* const rowp0 = base + (size_t)(row0 - fr + rr - rsub) * ldc + col0;
#pragma unroll
        for (int ai = 0; ai < 2; ++ai)
#pragma unroll
            for (int m = 0; m < 4; ++m) { bf16* rowp = rowp0 + (size_t)(ai * 128 + m * 16) * (size_t)ldc;
                pg8::u32x4 w[2];
#pragma unroll
                for (int bj = 0; bj < 2; ++bj) { const pg8::f32x4 v0 = acc[ai][bj][m][0], v1 = acc[ai][bj][m][1];
                    w[bj].x = pg8::cvt_pk_bf16(v0[0], v0[1]); w[bj].y = pg8::cvt_pk_bf16(v0[2], v0[3]); w[bj].z = pg8::cvt_pk_bf16(v1[0], v1[1]); w[bj].w = pg8::cvt_pk_bf16(v1[2], v1[3]); }
                const pg8::u32x4 t0 = lane_t(w[0], srcb), t1 = lane_t(w[1], srcb);
                __builtin_nontemporal_store(t0, (pg8::u32x4*)rowp); __builtin_nontemporal_store(t1, (pg8::u32x4*)(rowp + 128)); }
    }
};
struct EpiMerge {
    static constexpr bool PERM = true;
    const bf16* GG; bf16* Y;
    __device__ __forceinline__ bool keep(const pg8::Unit& u) const { return u.flag == 0; }
    __device__ __forceinline__ void operator()(pg8::f32x4 (&acc)[2][2][4][2], const pg8::Unit& u, int wr, int wc, int fr, int fq) const {
        const int row0 = u.pm * 256 + wr * 64 + fr, col0 = u.pn * 256 + wc * 32 + 8 * fq; LANE_T_SETUP
        const bf16* gp = GG + (size_t)row0 * 4096 + col0;
        if (u.flag == 0) {
            pg8::u32x4 gmr[8], gar[8];
#pragma unroll
            for (int m = 0; m < 4; ++m)
#pragma unroll
                for (int bj = 0; bj < 2; ++bj) { const bf16* q = gp + (size_t)(m * 16) * 4096 + bj * 128; gmr[2 * m + bj] = *(const pg8::u32x4*)(q + 2048); gar[2 * m + bj] = *(const pg8::u32x4*)q; }
#pragma unroll
            for (int ai = 0; ai < 2; ++ai)
#pragma unroll
                for (int m = 0; m < 4; ++m)
#pragma unroll
                    for (int bj = 0; bj < 2; ++bj) { const pg8::u32x4 gm = gmr[2 * m + bj], ga = gar[2 * m + bj];
                        if (ai == 0) { const bf16* q = gp + (size_t)(128 + m * 16) * 4096 + bj * 128; gmr[2 * m + bj] = *(const pg8::u32x4*)(q + 2048); gar[2 * m + bj] = *(const pg8::u32x4*)q; }
#pragma unroll
                        for (int j = 0; j < 4; ++j) { const float em0 = __expf(-fminf(fmaxf(bflo(gm[j]), -30.f), 30.f)), em1 = __expf(-fminf(fmaxf(bfhi(gm[j]), -30.f), 30.f));
                            const float ea0 = __expf(-fminf(fmaxf(bflo(ga[j]), -30.f), 30.f)), ea1 = __expf(-fminf(fmaxf(bfhi(ga[j]), -30.f), 30.f));
                            const float r0 = (1.f + em0) * frcp(1.f + ea0), r1 = (1.f + em1) * frcp(1.f + ea1);
                            acc[ai][bj][m][j >> 1][(2 * j) & 3] *= r0; acc[ai][bj][m][j >> 1][(2 * j + 1) & 3] *= r1; } }
        } else {
            pg8::u32x4 gmr[2][8];
#pragma unroll
            for (int ai = 0; ai < 2; ++ai)
#pragma unroll
                for (int m = 0; m < 4; ++m)
#pragma unroll
                    for (int bj = 0; bj < 2; ++bj) gmr[ai][2 * m + bj] = *(const pg8::u32x4*)(gp + (size_t)(ai * 128 + m * 16) * 4096 + bj * 128 + 2048);
            bf16* yp = Y + ((((size_t)u.pm * 32 + u.pn * 4 + (wc >> 1)) * 256 + (wr * 64 + rr)) << 6) + 32 * (wc & 1) + 8 * cq;
#pragma unroll
            for (int ai = 0; ai < 2; ++ai)
#pragma unroll
                for (int m = 0; m < 4; ++m) { pg8::u32x4 w[2];
#pragma unroll
                    for (int bj = 0; bj < 2; ++bj) { const pg8::u32x4 gm = gmr[ai][2 * m + bj]; float v[8];
#pragma unroll
                        for (int j = 0; j < 4; ++j) { const float em0 = __expf(-fminf(fmaxf(bflo(gm[j]), -30.f), 30.f)), em1 = __expf(-fminf(fmaxf(bfhi(gm[j]), -30.f), 30.f));
                            v[2 * j] = acc[ai][bj][m][j >> 1][(2 * j) & 3] * frcp(1.f + em0); v[2 * j + 1] = acc[ai][bj][m][j >> 1][(2 * j + 1) & 3] * frcp(1.f + em1); }
                        w[bj].x = pg8::cvt_pk_bf16(v[0], v[1]); w[bj].y = pg8::cvt_pk_bf16(v[2], v[3]); w[bj].z = pg8::cvt_pk_bf16(v[4], v[5]); w[bj].w = pg8::cvt_pk_bf16(v[6], v[7]); }
                    const pg8::u32x4 t0 = lane_t(w[0], srcb), t1 = lane_t(w[1], srcb);
                    bf16* o = yp + (size_t)(ai * 128 + m * 16) * 64; *(pg8::u32x4*)o = t0; *(pg8::u32x4*)(o + 2 * 256 * 64) = t1; }
        }
    }
};
struct EpiResid {
    static constexpr bool PERM = false;
    const float* base; float* out; const float* gate;
    __device__ __forceinline__ bool keep(const pg8::Unit&) const { return false; }
    __device__ __forceinline__ void operator()(pg8::f32x4 (&acc)[2][2][4][2], const pg8::Unit& u, int wr, int wc, int fr, int fq) const {
        const int row0 = u.pm * 256 + wr * 64 + fr, col0 = u.pn * 256 + wc * 32 + 4 * fq; const float* gp = gate + (size_t)(u.pm >> 5) * NMOD + col0;
        pg8::f32x4 gv[2][2];
#pragma unroll
        for (int bj = 0; bj < 2; ++bj)
#pragma unroll
            for (int n = 0; n < 2; ++n) gv[bj][n] = *(const pg8::f32x4*)(gp + bj * 128 + n * 16);
#pragma unroll
        for (int ai = 0; ai < 2; ++ai)
#pragma unroll
            for (int m = 0; m < 4; ++m) { const size_t off = (size_t)(row0 + ai * 128 + m * 16) * D + col0;
#pragma unroll
                for (int bj = 0; bj < 2; ++bj)
#pragma unroll
                    for (int n = 0; n < 2; ++n) { const pg8::f32x4 bs = *(const pg8::f32x4*)(base + off + bj * 128 + n * 16); *(pg8::f32x4*)(out + off + bj * 128 + n * 16) = bs + gv[bj][n] * acc[ai][bj][m][n]; }
                asm volatile("" ::: "memory"); }
    }
};
struct EpiResidBf16 {
    static constexpr bool PERM = true;
    const float* base; bf16* out; const float* gate;
    __device__ __forceinline__ bool keep(const pg8::Unit&) const { return false; }
    __device__ __forceinline__ void operator()(pg8::f32x4 (&acc)[2][2][4][2], const pg8::Unit& u, int wr, int wc, int fr, int fq) const {
        const int row0 = u.pm * 256 + wr * 64 + fr, col0 = u.pn * 256 + wc * 32 + 8 * fq; const float* gp = gate + (size_t)(u.pm >> 5) * NMOD + col0; LANE_T_SETUP
        const float* bp = base + (size_t)row0 * D + col0;
        pg8::f32x4 br[8][2];
#pragma unroll
        for (int m = 0; m < 4; ++m)
#pragma unroll
            for (int bj = 0; bj < 2; ++bj) { const float* q = bp + (size_t)(m * 16) * D + bj * 128; br[2 * m + bj][0] = *(const pg8::f32x4*)q; br[2 * m + bj][1] = *(const pg8::f32x4*)(q + 4); }
        pg8::f32x4 gv[2][2];
#pragma unroll
        for (int bj = 0; bj < 2; ++bj)
#pragma unroll
            for (int n = 0; n < 2; ++n) gv[bj][n] = *(const pg8::f32x4*)(gp + bj * 128 + n * 4);
        bf16* op = out + (size_t)(row0 - fr + rr) * D + col0 + 8 * (cq - fq);
#pragma unroll
        for (int ai = 0; ai < 2; ++ai)
#pragma unroll
            for (int m = 0; m < 4; ++m) { pg8::u32x4 w[2];
#pragma unroll
                for (int bj = 0; bj < 2; ++bj) { const pg8::f32x4 b0 = br[2 * m + bj][0], b1 = br[2 * m + bj][1];
                    if (ai == 0) { const float* q = bp + (size_t)(128 + m * 16) * D + bj * 128; br[2 * m + bj][0] = *(const pg8::f32x4*)q; br[2 * m + bj][1] = *(const pg8::f32x4*)(q + 4); }
                    const pg8::f32x4 v0 = b0 + gv[bj][0] * acc[ai][bj][m][0], v1 = b1 + gv[bj][1] * acc[ai][bj][m][1];
                    w[bj].x = pg8::cvt_pk_bf16(v0[0], v0[1]); w[bj].y = pg8::cvt_pk_bf16(v0[2], v0[3]); w[bj].z = pg8::cvt_pk_bf16(v1[0], v1[1]); w[bj].w = pg8::cvt_pk_bf16(v1[2], v1[3]); }
                const pg8::u32x4 t0 = lane_t(w[0], srcb), t1 = lane_t(w[1], srcb);
                bf16* o = op + (size_t)(ai * 128 + m * 16) * D; *(pg8::u32x4*)o = t0; *(pg8::u32x4*)(o + 128) = t1; }
    }
};
struct EpiResidBB {
    static constexpr bool PERM = true;
    const bf16* base; bf16* out; const float* gate;
    __device__ __forceinline__ bool keep(const pg8::Unit&) const { return false; }
    __device__ __forceinline__ void operator()(pg8::f32x4 (&acc)[2][2][4][2], const pg8::Unit& u, int wr, int wc, int fr, int fq) const {
        const int row0 = u.pm * 256 + wr * 64 + fr, col0 = u.pn * 256 + wc * 32 + 8 * fq; const float* gp = gate + (size_t)(u.pm >> 5) * NMOD + col0; LANE_T_SETUP
        pg8::u32x4 bw[2][8];
        const bf16* bp = base + (size_t)row0 * D + col0;
#pragma unroll
        for (int ai = 0; ai < 2; ++ai)
#pragma unroll
            for (int m = 0; m < 4; ++m)
#pragma unroll
                for (int bj = 0; bj < 2; ++bj) bw[ai][2 * m + bj] = *(const pg8::u32x4*)(bp + (size_t)(ai * 128 + m * 16) * D + bj * 128);
        pg8::f32x4 gv[2][2];
#pragma unroll
        for (int bj = 0; bj < 2; ++bj)
#pragma unroll
            for (int n = 0; n < 2; ++n) gv[bj][n] = *(const pg8::f32x4*)(gp + bj * 128 + n * 4);
        bf16* op = out + (size_t)(row0 - fr + rr) * D + col0 + 8 * (cq - fq);
#pragma unroll
        for (int ai = 0; ai < 2; ++ai)
#pragma unroll
            for (int m = 0; m < 4; ++m) { pg8::u32x4 w[2];
#pragma unroll
                for (int bj = 0; bj < 2; ++bj) { const pg8::u32x4 b = bw[ai][2 * m + bj];
                    const pg8::f32x4 b0 = (pg8::f32x4){bflo(b.x), bfhi(b.x), bflo(b.y), bfhi(b.y)}, b1 = (pg8::f32x4){bflo(b.z), bfhi(b.z), bflo(b.w), bfhi(b.w)};
                    const pg8::f32x4 v0 = b0 + gv[bj][0] * acc[ai][bj][m][0], v1 = b1 + gv[bj][1] * acc[ai][bj][m][1];
                    w[bj].x = pg8::cvt_pk_bf16(v0[0], v0[1]); w[bj].y = pg8::cvt_pk_bf16(v0[2], v0[3]); w[bj].z = pg8::cvt_pk_bf16(v1[0], v1[1]); w[bj].w = pg8::cvt_pk_bf16(v1[2], v1[3]); }
                const pg8::u32x4 t0 = lane_t(w[0], srcb), t1 = lane_t(w[1], srcb);
                bf16* o = op + (size_t)(ai * 128 + m * 16) * D; *(pg8::u32x4*)o = t0; *(pg8::u32x4*)(o + 128) = t1; }
    }
};
struct EpiSwiGLU {
    static constexpr bool PERM = true;
    bf16* HDN;
    __device__ __forceinline__ bool keep(const pg8::Unit&) const { return false; }
    __device__ __forceinline__ void operator()(pg8::f32x4 (&acc)[2][2][4][2], const pg8::Unit& u, int wr, int wc, int fr, int fq) const {
        LANE_T_SETUP const int row0 = u.pm * 256 + wr * 64 + rr, col0 = u.pn * 128 + wc * 32 + 8 * cq;
#pragma unroll
        for (int ai = 0; ai < 2; ++ai)
#pragma unroll
            for (int m2 = 0; m2 < 4; m2 += 2) { pg8::u32x4 w[2];
#pragma unroll
                for (int mm = 0; mm < 2; ++mm) { const int m = m2 + mm; float v[8];
#pragma unroll
                    for (int j = 0; j < 8; ++j) { const float gt = acc[ai][0][m][j >> 2][j & 3], up = acc[ai][1][m][j >> 2][j & 3]; v[j] = gt * up * frcp(1.f + __expf(-gt)); }
                    w[mm].x = pg8::cvt_pk_bf16(v[0], v[1]); w[mm].y = pg8::cvt_pk_bf16(v[2], v[3]); w[mm].z = pg8::cvt_pk_bf16(v[4], v[5]); w[mm].w = pg8::cvt_pk_bf16(v[6], v[7]); }
                const pg8::u32x4 t0 = lane_t(w[0], srcb), t1 = lane_t(w[1], srcb);
                bf16* hp_ = HDN + ((((size_t)u.pm * 88 + u.pn * 2 + (wc >> 1)) * 256 + (wr * 64 + rr + ai * 128 + m2 * 16)) << 6) + 32 * (wc & 1) + 8 * cq;
                __builtin_nontemporal_store(t0, (pg8::u32x4*)hp_); __builtin_nontemporal_store(t1, (pg8::u32x4*)(hp_ + 16 * 64)); }
    }
};

struct CItem { const float* src; bf16* dst; int src_ld, k0, c0, dst_ld, drow0, dk0, rperm; float scale; };
__device__ __forceinline__ void ci_load(const CItem& c, f32x4 (&t)[8], int lane) {
    const int kr = lane >> 3, c4 = (lane & 7) * 4;
    if (c.src) {
#pragma unroll
        for (int i = 0; i < 8; ++i) t[i] = *(const GAS f32x4*)(c.src + (size_t)(c.k0 + 8 * kr + i) * c.src_ld + c.c0 + c4);
    } else {
#pragma unroll
        for (int i = 0; i < 8; ++i) t[i] = (f32x4){0.f, 0.f, 0.f, 0.f};
    }
}
__device__ __forceinline__ void ci_store(const CItem& c, const f32x4 (&t)[8], int lane) {
    const int kr = lane >> 3, c4 = (lane & 7) * 4; const float scale = c.scale; const int rperm = c.rperm;
#pragma unroll
    for (int j = 0; j < 4; ++j) { const int n = c4 + j;
        v4u o; o.x = pg8::cvt_pk_bf16(t[0][j] * scale, t[1][j] * scale); o.y = pg8::cvt_pk_bf16(t[2][j] * scale, t[3][j] * scale); o.z = pg8::cvt_pk_bf16(t[4][j] * scale, t[5][j] * scale); o.w = pg8::cvt_pk_bf16(t[6][j] * scale, t[7][j] * scale);
        const int drow = rperm < 0 ? (c.drow0 + n) : (c.drow0 + 32 * (2 * (rperm >> 1) + (n >> 4)) + 8 * ((n >> 2) & 3) + 4 * (rperm & 1) + (n & 3));
        { const int rt = drow & 255, rw = rt & 127, sg = rw & 31, R = (rw & ~31) + 16 * ((sg >> 2) & 1) + 4 * (sg >> 3) + (sg & 3);
          const size_t blk = ((size_t)(drow >> 8) * (c.dst_ld >> 6) + ((c.dk0 + c.k0) >> 6)) * 32768 + (size_t)(rt >> 7) * 16384 + (size_t)pg8::lds_byte(R, 8 * kr);
          *(GAS v4u*)((GAS char*)c.dst + blk) = o; } }
}
template <class ItemFn> __device__ __forceinline__ void conv_pipeline(int first, int stride, int count, const ItemFn& item) {
    const int lane = (int)(threadIdx.x & 63);
    int it = first; if (it >= count) return;
    CItem cur = item(it); f32x4 t[8]; ci_load(cur, t, lane);
    for (;;) { const int nx = it + stride; const bool more = nx < count; CItem nxt = cur; f32x4 u[8];
        if (more) { nxt = item(nx); ci_load(nxt, u, lane); }
        ci_store(cur, t, lane);
        if (!more) break;
        cur = nxt; it = nx;
#pragma unroll
        for (int i = 0; i < 8; ++i) t[i] = u[i]; }
}
__device__ __forceinline__ void phase_prologue(Frame& F, bool late_ffn) {
    {
        LAS float* sv = (LAS float*)(F.lds);
        for (int unit = F.bid; unit < 256; unit += F.G) {
            const int ks = unit >> 3, cs = unit & 7;
            __syncthreads();
            if ((int)threadIdx.x < 320) { const int r = (int)threadIdx.x >> 6, kk = (int)threadIdx.x & 63; const float v = r < 4 ? F.c[r * D + ks * 64 + kk] : F.c_ctx[ks * 64 + kk]; sv[(int)threadIdx.x] = v / (1.f + __expf(-v)); }
            __syncthreads();
            float a[5][3];
#pragma unroll
            for (int r = 0; r < 5; ++r)
#pragma unroll
                for (int j = 0; j < 3; ++j) a[r][j] = 0.f;
            const float* wp = F.w_ada + (size_t)(ks * 64) * NMOD + cs * 1536 + (int)threadIdx.x;
#pragma unroll 4
            for (int kk = 0; kk < 64; ++kk) {
                const float w0 = wp[(size_t)kk * NMOD], w1 = wp[(size_t)kk * NMOD + 512], w2 = wp[(size_t)kk * NMOD + 1024];
#pragma unroll
                for (int r = 0; r < 5; ++r) { const float s = sv[r * 64 + kk]; a[r][0] += s * w0; a[r][1] += s * w1; a[r][2] += s * w2; }
            }
#pragma unroll
            for (int r = 0; r < 5; ++r)
#pragma unroll
                for (int j = 0; j < 3; ++j) F.MODP[((size_t)ks * 5 + r) * NMOD + cs * 1536 + (int)threadIdx.x + 512 * j] = a[r][j];
        }
        __syncthreads();
    }
    for (int i = F.bid * 512 + (int)threadIdx.x; i < 128 * 32; i += F.G * 512) { const int pos = i >> 5, f = i & 31; const float inv = powf(10000.0f, -(float)f / 32.0f); const float ang = (float)pos * inv; F.ROPE[i] = cosf(ang); F.ROPE[4096 + i] = sinf(ang); }
    const int gw = F.bid * NWAVES + F.wave, NGW = F.G * NWAVES;
    constexpr int I_IN = 32 * 424, I_AP = 32 * 64, I_MP = 32 * 64, I_OUT = 32 * 64, I_FFI = 32 * 352, I_FFO = 88 * 64;
    const int NITEMS = late_ffn ? (I_IN + I_AP + I_MP + I_OUT) : (I_IN + I_AP + I_MP + I_OUT + I_FFI + I_FFO);
    conv_pipeline(gw, NGW, NITEMS, [&](int it) -> CItem { int r = it; CItem c; c.dk0 = 0; c.rperm = -1; c.scale = 1.f;
        if (r < I_IN) { const int kb = r / 424, nb = r % 424; int src;
            c.src = F.w_in; c.src_ld = W_IN_COLS; c.k0 = 64 * kb; c.dst = F.WIN; c.dst_ld = D; c.drow0 = 32 * nb;
            if (nb < 128) { src = 32 * nb; if (nb < 16) { c.rperm = nb & 3; c.drow0 = 128 * (nb >> 2); } }
            else if (nb < 192) { src = 4128 + 32 * (nb - 128); c.scale = QSCALE; c.rperm = (nb - 128) & 3; c.drow0 = 4096 + 128 * ((nb - 128) >> 2); }
            else if (nb < 224) { src = 6176 + 32 * (nb - 192); c.scale = QSCALE; } else if (nb < 416) src = 7200 + 32 * (nb - 224); else if (nb == 416) src = 4096; else { src = 0; c.src = nullptr; }
            c.c0 = src; return c; }
        r -= I_IN;
        if (r < I_AP) { c.src = F.w_attn_proj; c.src_ld = D; c.k0 = 64 * (r / 64); c.c0 = 32 * (r % 64); c.dst = F.WAM; c.dst_ld = 4096; c.drow0 = 32 * (r % 64); return c; } r -= I_AP;
        if (r < I_MP) { c.src = F.w_mlstm_proj; c.src_ld = D; c.k0 = 64 * (r / 64); c.c0 = 32 * (r % 64); c.dst = F.WAM; c.dst_ld = 4096; c.drow0 = 32 * (r % 64); c.dk0 = 2048; return c; } r -= I_MP;
        if (r < I_OUT) { c.src = F.w_out; c.src_ld = D; c.k0 = 64 * (r / 64); c.c0 = 32 * (r % 64); c.dst = F.WOUT; c.dst_ld = D; c.drow0 = 32 * (r % 64); return c; } r -= I_OUT;
        if (r < I_FFI) { const int kb = r / 352, nb = r % 352, pn = nb >> 3, w = nb & 7;
            c.src = F.w_ffn_in; c.src_ld = 2 * DFF; c.k0 = 64 * kb; c.c0 = (w < 4) ? (128 * pn + 32 * w) : (DFF + 128 * pn + 32 * (w - 4)); c.dst = F.WFFI; c.dst_ld = D; c.drow0 = 32 * nb; return c; }
        r -= I_FFI;
        c.src = F.w_ffn_out; c.src_ld = D; c.k0 = 64 * (r / 64); c.c0 = 32 * (r % 64); c.dst = F.WFFO; c.dst_ld = DFF; c.drow0 = 32 * (r % 64); return c; });
}
__device__ __forceinline__ void norm_mod_rows_b(Frame& F, const bf16* X, int row_lo, int row_hi, const float* g, bf16* O, int chunk_shift, int chunk_scale) {
    const int lane = (int)(threadIdx.x & 63); int cur_b = -1; f32x4 ca[4][2], cb[4][2];
    if (row_lo >= row_hi) return;
    v4u nx[4];
    { const GAS v4u* xr = (const GAS v4u*)(X + (size_t)row_lo * D) + lane;
#pragma unroll
      for (int j = 0; j < 4; ++j) nx[j] = xr[64 * j]; }
    for (int row = row_lo; row < row_hi; ++row) {
        const int b = row >> 13;
        if (b != cur_b) { cur_b = b; const float* mp = F.MOD + (size_t)b * NMOD;
#pragma unroll
            for (int j = 0; j < 4; ++j)
#pragma unroll
                for (int hh = 0; hh < 2; ++hh) { const int c = 8 * (64 * j + lane) + 4 * hh; const f32x4 gg = *(const GAS f32x4*)(g + c), sc = *(const GAS f32x4*)(mp + chunk_scale * D + c); ca[j][hh] = gg * (sc + 1.0f); cb[j][hh] = *(const GAS f32x4*)(mp + chunk_shift * D + c); } }
        v4u cur[4];
#pragma unroll
        for (int j = 0; j < 4; ++j) cur[j] = nx[j];
        if (row + 1 < row_hi) { const GAS v4u* xr = (const GAS v4u*)(X + (size_t)(row + 1) * D) + lane;
#pragma unroll
            for (int j = 0; j < 4; ++j) nx[j] = xr[64 * j]; }
        f32x4 v[4][2]; float s = 0.f;
#pragma unroll
        for (int j = 0; j < 4; ++j) { const v4u w = cur[j]; v[j][0] = (f32x4){bflo(w.x), bfhi(w.x), bflo(w.y), bfhi(w.y)}; v[j][1] = (f32x4){bflo(w.z), bfhi(w.z), bflo(w.w), bfhi(w.w)};
            s += (v[j][0].x * v[j][0].x + v[j][0].y * v[j][0].y) + (v[j][0].z * v[j][0].z + v[j][0].w * v[j][0].w) + (v[j][1].x * v[j][1].x + v[j][1].y * v[j][1].y) + (v[j][1].z * v[j][1].z + v[j][1].w * v[j][1].w); }
        const float r = __builtin_amdgcn_rsqf(wave_sum_dpp(s) * (1.0f / D) + NORM_EPS);
        GAS v4u* o16 = (GAS v4u*)(O + ((((size_t)(row >> 8) * 32 + (lane >> 3)) * 256 + (row & 255)) << 6) + 8 * (lane & 7));
#pragma unroll
        for (int j = 0; j < 4; ++j) { const f32x4 y0 = (v[j][0] * r) * ca[j][0] + cb[j][0], y1 = (v[j][1] * r) * ca[j][1] + cb[j][1]; v4u w; w.x = pg8::cvt_pk_bf16(y0.x, y0.y); w.y = pg8::cvt_pk_bf16(y0.z, y0.w); w.z = pg8::cvt_pk_bf16(y1.x, y1.y); w.w = pg8::cvt_pk_bf16(y1.z, y1.w); o16[(size_t)j * 8 * 256 * 64 / 8] = w; }
    }
}
__device__ __forceinline__ void convert_ffn_weights_queue(Frame& F) {
    constexpr int I_FFI = 32 * 352, I_FFO = 88 * 64, TOTAL = I_FFI + I_FFO, BATCH = 8;
    unsigned* qh = (unsigned*)(F.ctl + CW_QUEUE);
    auto item = [&](int r) -> CItem { CItem c; c.dk0 = 0; c.rperm = -1; c.scale = 1.f;
        if (r < I_FFI) { const int kb = r / 352, nb = r % 352, pn = nb >> 3, w = nb & 7;
            c.src = F.w_ffn_in; c.src_ld = 2 * DFF; c.k0 = 64 * kb; c.c0 = (w < 4) ? (128 * pn + 32 * w) : (DFF + 128 * pn + 32 * (w - 4)); c.dst = F.WFFI; c.dst_ld = D; c.drow0 = 32 * nb; return c; }
        const int r2 = r - I_FFI; c.src = F.w_ffn_out; c.src_ld = D; c.k0 = 64 * (r2 / 64); c.c0 = 32 * (r2 % 64); c.dst = F.WFFO; c.dst_ld = DFF; c.drow0 = 32 * (r2 % 64); return c; };
    auto grab = [&]() -> int { unsigned v = 0u; if ((threadIdx.x & 63) == 0) v = xb_add(qh, (unsigned)BATCH); return (int)__builtin_amdgcn_readfirstlane(v); };
    int base = grab();
    while (base < TOTAL) { const int nextb = grab(); const int end = base + BATCH < TOTAL ? base + BATCH : TOTAL; conv_pipeline(base, 1, end, item); base = nextb; }
}
__device__ __forceinline__ void convert_ffn_weights_one_batch(Frame& F) {
    constexpr int I_FFI = 32 * 352, I_FFO = 88 * 64, TOTAL = I_FFI + I_FFO, BATCH = 8;
    unsigned* qh = (unsigned*)(F.ctl + CW_QUEUE);
    auto item = [&](int r) -> CItem { CItem c; c.dk0 = 0; c.rperm = -1; c.scale = 1.f;
        if (r < I_FFI) { const int kb = r / 352, nb = r % 352, pn = nb >> 3, w = nb & 7;
            c.src = F.w_ffn_in; c.src_ld = 2 * DFF; c.k0 = 64 * kb; c.c0 = (w < 4) ? (128 * pn + 32 * w) : (DFF + 128 * pn + 32 * (w - 4)); c.dst = F.WFFI; c.dst_ld = D; c.drow0 = 32 * nb; return c; }
        const int r2 = r - I_FFI; c.src = F.w_ffn_out; c.src_ld = D; c.k0 = 64 * (r2 / 64); c.c0 = 32 * (r2 % 64); c.dst = F.WFFO; c.dst_ld = DFF; c.drow0 = 32 * (r2 % 64); return c; };
    unsigned v = 0u; if ((threadIdx.x & 63) == 0) v = xb_add(qh, (unsigned)BATCH); const int base = (int)__builtin_amdgcn_readfirstlane(v);
    if (base < TOTAL) { const int end = base + BATCH < TOTAL ? base + BATCH : TOTAL; conv_pipeline(base, 1, end, item); }
}
__device__ __forceinline__ void phase_mod_reduce(Frame& F) {
    for (int e = F.bid * 512 + (int)threadIdx.x; e < 5 * NMOD; e += F.G * 512) { const int n = e % NMOD; float s = F.b_ada[n];
#pragma unroll 8
        for (int ks = 0; ks < 32; ++ks) s += F.MODP[(size_t)ks * 5 * NMOD + e];
        F.MOD[e] = s; }
}
__device__ __forceinline__ void norm_mod_rows(Frame& F, const float* X, int row_lo, int row_hi, const float* g, bf16* O, int chunk_shift, int chunk_scale, bool ctx_tail) {
    const int lane = (int)(threadIdx.x & 63); int cur_b = -1; f32x4 ca[8], cb[8];
    if (row_lo >= row_hi) return;
    f32x4 nx[8];
    { const float* xr = (ctx_tail && row_lo >= MLAT) ? (F.ctx + (size_t)(row_lo - MLAT) * D) : (X + (size_t)row_lo * D);
#pragma unroll
      for (int j = 0; j < 8; ++j) nx[j] = *(const GAS f32x4*)(xr + 256 * j + 4 * lane); }
    for (int row = row_lo; row < row_hi; ++row) {
        const int b = (ctx_tail && row >= MLAT) ? 4 : (row >> 13);
        if (b != cur_b) { cur_b = b; const float* mp = F.MOD + (size_t)b * NMOD;
#pragma unroll
            for (int j = 0; j < 8; ++j) { const f32x4 gg = *(const GAS f32x4*)(g + 256 * j + 4 * lane), sc = *(const GAS f32x4*)(mp + chunk_scale * D + 256 * j + 4 * lane); ca[j] = gg * (sc + 1.0f); cb[j] = *(const GAS f32x4*)(mp + chunk_shift * D + 256 * j + 4 * lane); } }
        f32x4 v[8]; float s = 0.f;
#pragma unroll
        for (int j = 0; j < 8; ++j) v[j] = nx[j];
        if (row + 1 < row_hi) { const int rn = row + 1; const float* xr = (ctx_tail && rn >= MLAT) ? (F.ctx + (size_t)(rn - MLAT) * D) : (X + (size_t)rn * D);
#pragma unroll
            for (int j = 0; j < 8; ++j) nx[j] = *(const GAS f32x4*)(xr + 256 * j + 4 * lane); }
#pragma unroll
        for (int j = 0; j < 8; ++j) s += (v[j].x * v[j].x + v[j].y * v[j].y) + (v[j].z * v[j].z + v[j].w * v[j].w);
        const float r = __builtin_amdgcn_rsqf(wave_sum_dpp(s) * (1.0f / D) + NORM_EPS);
        GAS v2u* o8 = (GAS v2u*)(O + ((((size_t)(row >> 8) * 32 + (lane >> 4)) * 256 + (row & 255)) << 6) + 4 * (lane & 15));
#pragma unroll
        for (int j = 0; j < 8; ++j) { const f32x4 y = (v[j] * r) * ca[j] + cb[j]; v2u w; w.x = pg8::cvt_pk_bf16(y.x, y.y); w.y = pg8::cvt_pk_bf16(y.z, y.w); o8[(size_t)j * 4 * 256 * 64 / 4] = w; }
    }
}
__device__ __forceinline__ void phase_gate_scan(Frame& F) {
    const int gw = F.bid * NWAVES + F.wave, NGW = F.G * NWAVES, lane = (int)(threadIdx.x & 63);
    for (int task = gw; task < 64 * 66; task += NGW) {
        const int bhd = task / 66, ci = task % 66, dir = bhd & 1, h = (bhd >> 1) & 7, b = bhd >> 4;
        const bool lat = ci >= 2; const int ac = lat ? (dir ? 63 - (ci - 2) : (ci - 2)) : (dir ? 1 - ci : ci);
        const size_t gr = lat ? ((size_t)b * SEQ + 128 * ac) : ((size_t)MLAT + (size_t)b * CL + 128 * ac);
        const float bi = F.b_gates[dir * 16 + h], bfg = F.b_gates[dir * 16 + 8 + h];
        float l[2], f[2];
#pragma unroll
        for (int e = 0; e < 2; ++e) { const int p = 2 * lane + e; const int t = dir ? 127 - p : p; const float* gp = F.GATES + (gr + t) * 32 + dir * 16 + h; l[e] = gp[0] + bi; const float z = gp[8] + bfg;
            f[e] = z >= 0.f ? -log1pf(expf(-z)) : z - log1pf(expf(z)); }
        float sc = f[0] + f[1];
#pragma unroll
        for (int o = 1; o < 64; o <<= 1) { const float t = __shfl_up(sc, o); if (lane >= o) sc += t; }
        const float b1 = sc, b0 = sc - f[1], u0 = l[0] - b0, u1 = l[1] - b1;
        const float umax = wave_max(fmaxf(u0, u1)), bend = __shfl(b1, 63);
        const size_t o = (size_t)bhd * 8448 + ci * 128 + 2 * lane;
        *(GAS v2u*)(F.GU + o) = (v2u){__builtin_bit_cast(unsigned, u0), __builtin_bit_cast(unsigned, u1)};
        *(GAS v2u*)(F.GB + o) = (v2u){__builtin_bit_cast(unsigned, b0), __builtin_bit_cast(unsigned, b1)};
        if (lane == 0) { F.GS[(size_t)task * 2] = umax; F.GS[(size_t)task * 2 + 1] = bend; }
    }
}
namespace attn {
using bf16x8 = __attribute__((ext_vector_type(8))) short;
using s16x4  = __attribute__((ext_vector_type(4))) short;
using f32x16 = __attribute__((ext_vector_type(16))) float;
using u32x4  = __attribute__((ext_vector_type(4))) unsigned;
constexpr int QBLK = 32, KVBLK = 64, LDK = 512, LDQ = 4096;
constexpr float THR = 6.f;
constexpr int SHM_V = KVBLK * 128 * 2, SHM_K = KVBLK * 128 * 2, SHM_ATTN = 2 * SHM_V + 2 * SHM_K + 8 * 64 * 4;
#define KSWZ(row, colB) ((row) * 256 + ((colB) ^ (((row) & 7) << 4)))
#define SBAR() __builtin_amdgcn_sched_barrier(0)
__device__ __forceinline__ int crow(int r, int hi) { return (r & 3) + 8 * (r >> 2) + 4 * hi; }
__device__ __forceinline__ unsigned cvtpk(float lo, float hi) { unsigned r; asm volatile("v_cvt_pk_bf16_f32 %0, %1, %2" : "=v"(r) : "v"(lo), "v"(hi)); return r; }
__device__ __forceinline__ void partialSM(f32x16& p0, f32x16& p1, float& m_reg, float& mn, float& alpha) {
  constexpr float C = 1.4426950408889634f;
  float pmax = p0[0]; for (int r = 1; r < 16; ++r) pmax = fmaxf(pmax, p0[r]); for (int r = 0; r < 16; ++r) pmax = fmaxf(pmax, p1[r]);
  { auto rr = __builtin_amdgcn_permlane32_swap(__float_as_uint(pmax), __float_as_uint(pmax), false, false);
    pmax = fmaxf(__uint_as_float(rr[0]), __uint_as_float(rr[1])); }
  if (__builtin_expect(__all(pmax - m_reg <= THR), 1)) { mn = m_reg; alpha = 1.f; }
  else { mn = fmaxf(m_reg, pmax); alpha = __builtin_amdgcn_exp2f((m_reg - mn) * C); m_reg = mn; }
  float mnC = -mn * C;
  for (int r = 0; r < 16; ++r) p0[r] = fmaf(p0[r], C, mnC); for (int r = 0; r < 16; ++r) p1[r] = fmaf(p1[r], C, mnC);
  for (int r = 0; r < 16; ++r) p0[r] = __builtin_amdgcn_exp2f(p0[r]);
}
__device__ __forceinline__ void finishSM(f32x16& p0, f32x16& p1, float alpha, float& l_reg, bf16x8& pa0, bf16x8& pa1, bf16x8& pa2, bf16x8& pa3) {
  for (int r = 0; r < 16; ++r) p1[r] = __builtin_amdgcn_exp2f(p1[r]);
  float ps = 0; for (int r = 0; r < 16; ++r) ps += p0[r]; for (int r = 0; r < 16; ++r) ps += p1[r];
  { auto rr = __builtin_amdgcn_permlane32_swap(__float_as_uint(ps), __float_as_uint(ps), false, false);
    ps = __uint_as_float(rr[0]) + __uint_as_float(rr[1]); }
  l_reg = l_reg * alpha + ps;
#define PK4(P, BASE, OUT) do { unsigned a0 = cvtpk(P[BASE + 0], P[BASE + 1]), a1 = cvtpk(P[BASE + 2], P[BASE + 3]);   \
    unsigned b0 = cvtpk(P[BASE + 4], P[BASE + 5]), b1 = cvtpk(P[BASE + 6], P[BASE + 7]);                              \
    auto r0 = __builtin_amdgcn_permlane32_swap(a0, b0, false, false); auto r1 = __builtin_amdgcn_permlane32_swap(a1, b1, false, false); \
    u32x4 w = {r0[0], r1[0], r0[1], r1[1]}; OUT = *reinterpret_cast<bf16x8*>(&w); } while (0)
  PK4(p0, 0, pa0); PK4(p0, 8, pa1); PK4(p1, 0, pa2); PK4(p1, 8, pa3);
#undef PK4
}
template <int OFF> __device__ __forceinline__ f32x4 ldk128(int a) { f32x4 r; asm volatile("ds_read_b128 %0, %1 offset:%2" : "=&v"(r) : "v"(a), "i"(OFF) : "memory"); return r; }
__device__ __forceinline__ void qkt(f32x16& p0, f32x16& p1, const bf16* Ks, const bf16x8* qr, int r32, int hi) {
  const int rowb = (int)(uintptr_t)Ks + r32 * 256, y = (16 * hi) ^ ((r32 & 7) << 4);
  f32x4 f0, f1, f2; const f32x16 z16 = f32x16{};
#define QK_ADDR(D0) (rowb + (y ^ (32 * (D0))))
#define QK_WAIT(n, F) asm volatile("s_waitcnt lgkmcnt(" #n ")" : "+v"(F) :: "memory")
  f0 = ldk128<0>(QK_ADDR(0)); f1 = ldk128<8192>(QK_ADDR(0));
  f2 = ldk128<0>(QK_ADDR(1)); QK_WAIT(2, f0); p0 = __builtin_amdgcn_mfma_f32_32x32x16_bf16(__builtin_bit_cast(bf16x8, f0), qr[0], z16, 0, 0, 0);
  f0 = ldk128<8192>(QK_ADDR(1)); QK_WAIT(2, f1); p1 = __builtin_amdgcn_mfma_f32_32x32x16_bf16(__builtin_bit_cast(bf16x8, f1), qr[0], z16, 0, 0, 0);
  f1 = ldk128<0>(QK_ADDR(2)); QK_WAIT(2, f2); p0 = __builtin_amdgcn_mfma_f32_32x32x16_bf16(__builtin_bit_cast(bf16x8, f2), qr[1], p0, 0, 0, 0);
  f2 = ldk128<8192>(QK_ADDR(2)); QK_WAIT(2, f0); p1 = __builtin_amdgcn_mfma_f32_32x32x16_bf16(__builtin_bit_cast(bf16x8, f0), qr[1], p1, 0, 0, 0);
  f0 = ldk128<0>(QK_ADDR(3)); QK_WAIT(2, f1); p0 = __builtin_amdgcn_mfma_f32_32x32x16_bf16(__builtin_bit_cast(bf16x8, f1), qr[2], p0, 0, 0, 0);
  f1 = ldk128<8192>(QK_ADDR(3)); QK_WAIT(2, f2); p1 = __builtin_amdgcn_mfma_f32_32x32x16_bf16(__builtin_bit_cast(bf16x8, f2), qr[2], p1, 0, 0, 0);
  f2 = ldk128<0>(QK_ADDR(4)); QK_WAIT(2, f0); p0 = __builtin_amdgcn_mfma_f32_32x32x16_bf16(__builtin_bit_cast(bf16x8, f0), qr[3], p0, 0, 0, 0);
  f0 = ldk128<8192>(QK_ADDR(4)); QK_WAIT(2, f1); p1 = __builtin_amdgcn_mfma_f32_32x32x16_bf16(__builtin_bit_cast(bf16x8, f1), qr[3], p1, 0, 0, 0);
  f1 = ldk128<0>(QK_ADDR(5)); QK_WAIT(2, f2); p0 = __builtin_amdgcn_mfma_f32_32x32x16_bf16(__builtin_bit_cast(bf16x8, f2), qr[4], p0, 0, 0, 0);
  f2 = ldk128<8192>(QK_ADDR(5)); QK_WAIT(2, f0); p1 = __builtin_amdgcn_mfma_f32_32x32x16_bf16(__builtin_bit_cast(bf16x8, f0), qr[4], p1, 0, 0, 0);
  f0 = ldk128<0>(QK_ADDR(6)); QK_WAIT(2, f1); p0 = __builtin_amdgcn_mfma_f32_32x32x16_bf16(__builtin_bit_cast(bf16x8, f1), qr[5], p0, 0, 0, 0);
  f1 = ldk128<8192>(QK_ADDR(6)); QK_WAIT(2, f2); p1 = __builtin_amdgcn_mfma_f32_32x32x16_bf16(__builtin_bit_cast(bf16x8, f2), qr[5], p1, 0, 0, 0);
  f2 = ldk128<0>(QK_ADDR(7)); QK_WAIT(2, f0); p0 = __builtin_amdgcn_mfma_f32_32x32x16_bf16(__builtin_bit_cast(bf16x8, f0), qr[6], p0, 0, 0, 0);
  f0 = ldk128<8192>(QK_ADDR(7)); QK_WAIT(2, f1); p1 = __builtin_amdgcn_mfma_f32_32x32x16_bf16(__builtin_bit_cast(bf16x8, f1), qr[6], p1, 0, 0, 0);
  QK_WAIT(1, f2); p0 = __builtin_amdgcn_mfma_f32_32x32x16_bf16(__builtin_bit_cast(bf16x8, f2), qr[7], p0, 0, 0, 0);
  QK_WAIT(0, f0); p1 = __builtin_amdgcn_mfma_f32_32x32x16_bf16(__builtin_bit_cast(bf16x8, f0), qr[7], p1, 0, 0, 0);
#undef QK_ADDR
#undef QK_WAIT
}
__device__ __forceinline__ void band_mask(f32x16& p0, f32x16& p1, int kk0, int qi, int hi) {
  for (int r = 0; r < 16; ++r) { const int kk = kk0 + crow(r, hi); p0[r] = (kk >= qi && kk <= qi + 256) ? p0[r] : -1.0e30f; const int k2 = kk + 32; p1[r] = (k2 >= qi && k2 <= qi + 256) ? p1[r] : -1.0e30f; }
}
__device__ __forceinline__ int v_st(int k, int c) { const int kk = (k & ~0xC) | ((k & 4) << 1) | ((k & 8) >> 1); return ((kk >> 3) * 4 + (c >> 5)) * 512 + ((kk & 7) * 32 + (c & 31)) * 2; }
__device__ __forceinline__ int v_rd_base(int lane) { return ((lane & 3) << 3) | (((lane >> 2) & 3) << 6) | (((lane >> 4) & 1) << 5) | (((lane >> 5) & 1) << 8); }
constexpr int v_rd_off(int d0, int ks, int half) { return d0 * 512 + ks * 4096 + half * 2048; }
template <int OFF> __device__ __forceinline__ s16x4 tr_read(int vb) {
  s16x4 r; asm volatile("ds_read_b64_tr_b16 %0, %1 offset:%2" : "=&v"(r) : "v"(vb), "i"(OFF) : "memory"); return r;
}
template <int D0> __device__ __forceinline__ void pv_one(f32x16& od, int vb, bf16x8 pa0, bf16x8 pa1, bf16x8 pa2, bf16x8 pa3) {
  const s16x4 l0 = tr_read<v_rd_off(D0, 0, 0)>(vb), h0 = tr_read<v_rd_off(D0, 0, 1)>(vb), l1 = tr_read<v_rd_off(D0, 1, 0)>(vb), h1 = tr_read<v_rd_off(D0, 1, 1)>(vb);
  const s16x4 l2 = tr_read<v_rd_off(D0, 2, 0)>(vb), h2 = tr_read<v_rd_off(D0, 2, 1)>(vb), l3 = tr_read<v_rd_off(D0, 3, 0)>(vb), h3 = tr_read<v_rd_off(D0, 3, 1)>(vb);
  asm volatile("s_waitcnt lgkmcnt(0)" ::: "memory"); SBAR();
#define PK(L, H) (bf16x8){L[0], L[1], L[2], L[3], H[0], H[1], H[2], H[3]}
  od = __builtin_amdgcn_mfma_f32_32x32x16_bf16(pa0, PK(l0, h0), od, 0, 0, 0);
  od = __builtin_amdgcn_mfma_f32_32x32x16_bf16(pa1, PK(l1, h1), od, 0, 0, 0);
  od = __builtin_amdgcn_mfma_f32_32x32x16_bf16(pa2, PK(l2, h2), od, 0, 0, 0);
  od = __builtin_amdgcn_mfma_f32_32x32x16_bf16(pa3, PK(l3, h3), od, 0, 0, 0);
#undef PK
}
__device__ __forceinline__ void pv_d0(f32x16* o, int vb, bf16x8 pa0, bf16x8 pa1, bf16x8 pa2, bf16x8 pa3) {
  pv_one<0>(o[0], vb, pa0, pa1, pa2, pa3); pv_one<1>(o[1], vb, pa0, pa1, pa2, pa3); pv_one<2>(o[2], vb, pa0, pa1, pa2, pa3); pv_one<3>(o[3], vb, pa0, pa1, pa2, pa3);
}
template <bool STORE> __device__ __forceinline__ void attn_unit(bf16* AM, const bf16* KA, const bf16* VA, const bf16* CKA, const bf16* CVA, const float* sinkp, int b, int g, int qb, int pair, char* lds) {
  const int tid = threadIdx.x, wid = tid >> 6, lane = tid & 63, r32 = lane & 31, hi = lane >> 5;
  bf16* V_lds = (bf16*)lds; bf16* K_lds = (bf16*)(lds + 2 * SHM_V);
  float* ws = (float*)(lds + 2 * SHM_V + 2 * SHM_K) + wid * 64; float* li_l = ws; float* al_l = ws + 32;
  const int head = 4 * g + 2 * pair + (wid >> 2), qrow0 = 32 * (wid & 3), qi = qrow0 + r32;
  float m_reg = sinkp[head], l_reg = 1.f; f32x16 o[4] = {}; bf16x8 qr[8];
  bf16* Qrow = AM + (size_t)(b * SEQ + 128 * qb + qi) * LDQ + head * 128;
  const bf16* Qw = Qrow + hi * 8;
#pragma unroll
  for (int d0 = 0; d0 < 8; ++d0) qr[d0] = *reinterpret_cast<const bf16x8*>(Qw + d0 * 16);
  const int sr = tid >> 4, sc = (tid & 15) * 8, vst0 = v_st(sr, sc), vst1 = v_st(32 + sr, sc);
  const int vb0 = (int)(uintptr_t)V_lds + v_rd_base(lane);
  const int kstart = (qb == 0) ? 128 : 0, nloc = (qb == 0 || qb == SEQ / 128 - 1) ? 4 : 6, NT = nloc + 4;
  const size_t lrow0 = (size_t)(b * SEQ + 128 * (qb - 1) + kstart), crow0 = (size_t)(b * CL);
  struct { bf16x8 vs0, vs1, ks0, ks1; } sr_[1];
#define SLOAD(i, tile) do { const int _t = (tile); const bool _loc = _t < nloc; const size_t _row = _loc ? (lrow0 + 64 * _t) : (crow0 + 64 * (_t - nloc)); \
    const bf16* _kp = (_loc ? KA : CKA) + _row * LDK + g * 128 + sc; const bf16* _vp = (_loc ? VA : CVA) + _row * LDK + g * 128 + sc; \
    sr_[i].vs0 = *reinterpret_cast<const bf16x8*>(_vp + (size_t)sr * LDK); sr_[i].vs1 = *reinterpret_cast<const bf16x8*>(_vp + (size_t)(32 + sr) * LDK); \
    sr_[i].ks0 = *reinterpret_cast<const bf16x8*>(_kp + (size_t)sr * LDK); sr_[i].ks1 = *reinterpret_cast<const bf16x8*>(_kp + (size_t)(32 + sr) * LDK); } while (0)
#define SWRITE(b_, i) do { *(bf16x8*)((char*)V_lds + (b_) * SHM_V + vst0) = sr_[i].vs0;          \
    *(bf16x8*)((char*)V_lds + (b_) * SHM_V + vst1) = sr_[i].vs1; int kc = sc * 2;               \
    *(bf16x8*)((char*)K_lds + (b_) * SHM_K + KSWZ(sr, kc)) = sr_[i].ks0;                       \
    *(bf16x8*)((char*)K_lds + (b_) * SHM_K + KSWZ(32 + sr, kc)) = sr_[i].ks1; } while (0)
#define SWAIT() asm volatile("s_waitcnt vmcnt(0)" ::: "memory")
#define RESC(a) do { if (__any((a) < 1.f)) { if (hi == 0) al_l[r32] = (a); asm volatile("s_waitcnt lgkmcnt(0)" ::: "memory"); \
    for (int d = 0; d < 4; ++d) for (int r = 0; r < 16; ++r) o[d][r] *= al_l[crow(r, hi)]; } } while (0)
#define MASK(P0, P1, tile) do { const int _kk0 = kstart + 64 * (tile); if ((tile) < nloc && (_kk0 < 128 || _kk0 >= 256)) band_mask(P0, P1, _kk0, qi, hi); } while (0)
  f32x16 pA0, pA1, pB0, pB1; float mnA, mnB, alA, alB; bf16x8 pa0, pa1, pa2, pa3;
  SLOAD(0, 0); asm volatile("s_waitcnt vmcnt(0)" ::: "memory"); SWRITE(0, 0); SLOAD(0, 1); __syncthreads();
  qkt(pA0, pA1, K_lds, qr, r32, hi); MASK(pA0, pA1, 0); partialSM(pA0, pA1, m_reg, mnA, alA);
  SWAIT(); SWRITE(1, 0); SLOAD(0, 2); __syncthreads();
  RESC(alA);
  for (int j = 1; j + 1 < NT; j += 2) {
    SBAR(); qkt(pB0, pB1, (bf16*)((char*)K_lds + SHM_K), qr, r32, hi); MASK(pB0, pB1, j);
    finishSM(pA0, pA1, alA, l_reg, pa0, pa1, pa2, pa3); SBAR();
    pv_d0(o, vb0, pa0, pa1, pa2, pa3); partialSM(pB0, pB1, m_reg, mnB, alB);
    __syncthreads(); SWAIT(); SWRITE(0, 0); SLOAD(0, j + 2);
    RESC(alB); __syncthreads();
    SBAR(); qkt(pA0, pA1, K_lds, qr, r32, hi); MASK(pA0, pA1, j + 1);
    finishSM(pB0, pB1, alB, l_reg, pa0, pa1, pa2, pa3); SBAR();
    pv_d0(o, vb0 + (int)SHM_V, pa0, pa1, pa2, pa3); partialSM(pA0, pA1, m_reg, mnA, alA);
    __syncthreads(); SWAIT(); SWRITE(1, 0); if (j + 3 < NT) SLOAD(0, j + 3);
    RESC(alA); __syncthreads();
  }
  SBAR(); qkt(pB0, pB1, (bf16*)((char*)K_lds + SHM_K), qr, r32, hi); MASK(pB0, pB1, NT - 1);
  finishSM(pA0, pA1, alA, l_reg, pa0, pa1, pa2, pa3); SBAR();
  pv_d0(o, vb0, pa0, pa1, pa2, pa3); partialSM(pB0, pB1, m_reg, mnB, alB);
  __syncthreads(); RESC(alB);
  finishSM(pB0, pB1, alB, l_reg, pa0, pa1, pa2, pa3); SBAR();
  pv_d0(o, vb0 + (int)SHM_V, pa0, pa1, pa2, pa3);
  if (hi == 0) li_l[r32] = l_reg; asm volatile("s_waitcnt lgkmcnt(0)" ::: "memory");
  float rli[16];
#pragma unroll
  for (int r = 0; r < 16; ++r) rli[r] = __builtin_amdgcn_rcpf(li_l[crow(r, hi)]);
  bf16* Ow = AM + (size_t)(b * SEQ + 128 * qb + qrow0) * LDQ + head * 128;
  char* ost = lds + SHM_ATTN + wid * (32 * 144);
#pragma unroll
  for (int hf = 0; hf < 2; ++hf) {
#pragma unroll
    for (int r = 0; r < 16; ++r) { const int orow = crow(r, hi);
#pragma unroll
      for (int dd = 0; dd < 2; ++dd) { const float ov = o[2 * hf + dd][r] * rli[r]; *(bf16*)(ost + orow * 144 + (dd * 32 + r32) * 2) = (bf16)f2bf(ov); } }
    asm volatile("s_waitcnt lgkmcnt(0)" ::: "memory");
#pragma unroll
    for (int i = 0; i < 4; ++i) { const int idx = lane + 64 * i, row = idx >> 3, ch = idx & 7; const u32x4 v = *(const u32x4*)(ost + row * 144 + ch * 16);
      if (STORE) *(u32x4*)(Ow + (size_t)row * LDQ + hf * 64 + ch * 8) = v; else asm volatile("" :: "v"(v)); }
    asm volatile("s_waitcnt lgkmcnt(0)" ::: "memory");
  }
  __syncthreads();
#undef SLOAD
#undef SWRITE
#undef SWAIT
#undef RESC
#undef MASK
}
#undef KSWZ
#undef SBAR
}
__device__ __forceinline__ void phase_attn_range(Frame& F, unsigned char* lds_generic, int id0, int n_static) {
    unsigned* qh = (unsigned*)(F.ctl + CW_AQUEUE);
    for (int it = 0;; ++it) { int id;
        if (it < n_static) id = id0 + it;
        else { __syncthreads(); if (threadIdx.x == 0) F.MISC[12] = xb_add(qh, 1u); __syncthreads(); const int k = (int)F.MISC[12]; if (k >= 768) break; id = (k / 6) * 16 + 10 + (k % 6); }
        const int pair = id & 1, qb = (id >> 1) & 63, g = (id >> 7) & 3, b = id >> 9;
        attn::attn_unit<true>(F.AM, F.KA, F.VA, F.CKA, F.CVA, F.attn_sink, b, g, qb, pair, (char*)lds_generic); }
}
template <bool STORE> __device__ __forceinline__ void phase_attn_mfma(Frame& F, unsigned char* lds_generic) {
    const int per = (2048 + F.G - 1) / F.G;
    for (int i = 0; i < per; ++i) { const int id = F.bid * per + i; if (id >= 2048) break;
        const int pair = id & 1, qb = (id >> 1) & 63, g = (id >> 7) & 3, b = id >> 9;
        attn::attn_unit<STORE>(F.AM, F.KA, F.VA, F.CKA, F.CVA, F.attn_sink, b, g, qb, pair, (char*)lds_generic); }
}
namespace ml {
typedef short bf16x8 __attribute__((ext_vector_type(8)));
typedef short s16x4 __attribute__((ext_vector_type(4)));
typedef float f32x2 __attribute__((ext_vector_type(2)));
constexpr int KST = 288, VST = 144, PST = 288, CST = 288;
constexpr int K_OFF = 0, V_OFF = K_OFF + 128 * KST, P_OFF = V_OFF + 128 * VST, CT_OFF = P_OFF + 8 * 16 * PST, AR_OFF = CT_OFF + 80 * CST;
constexpr int AR_BUF = 1024;
constexpr int A_E = 0, A_EM = 512;
constexpr int ML_LDS = AR_OFF + 2 * AR_BUF;
template <int OFF> __device__ __forceinline__ s16x4 trr(int a) { s16x4 r; asm volatile("ds_read_b64_tr_b16 %0, %1 offset:%2" : "=&v"(r) : "v"(a), "i"(OFF) : "memory"); return r; }
template <int OFF> __device__ __forceinline__ f32x4 ldr128(int a) { f32x4 r; asm volatile("ds_read_b128 %0, %1 offset:%2" : "=&v"(r) : "v"(a), "i"(OFF) : "memory"); return r; }
#define ML_PK(L, H) (bf16x8){L[0], L[1], L[2], L[3], H[0], H[1], H[2], H[3]}
__device__ __forceinline__ float bfs(short h) { return __builtin_bit_cast(float, (unsigned)(unsigned short)h << 16); }
__device__ __forceinline__ void mlstm_unit(Frame& F, int unit, unsigned char* ldsg) {
    const int vs = unit & 3, dir = (unit >> 2) & 1, h = (unit >> 3) & 7, b = unit >> 6;
    const int w = F.wave, rb = (w < 4) ? w : 11 - w;
    LAS unsigned char* lds = F.lds;
    const int ldsbase = (int)(uintptr_t)ldsg;
    const float bi = F.b_gates[dir * 16 + h], bfg = F.b_gates[dir * 16 + 8 + h];
    bf16* Hd = dir ? F.H1 : F.H0;
    f32x4 Cst[5];
#pragma unroll
    for (int i = 0; i < 5; ++i) Cst[i] = (f32x4){0.f, 0.f, 0.f, 0.f};
    for (int i = (int)threadIdx.x; i < 80 * CST / 4; i += 512) ((LAS unsigned*)(lds + CT_OFF))[i] = 0u;
    if ((int)threadIdx.x < 128) *(LAS v4u*)(lds + V_OFF + (int)threadIdx.x * VST + 128) = (v4u){0x3f80u, 0u, 0u, 0u};
    v4u kreg[4], vreg[2]; bf16x8 qn[4];
#pragma unroll
    for (int i = 0; i < 4; ++i) qn[i] = (bf16x8){0, 0, 0, 0, 0, 0, 0, 0};
    const int bhd = (b * 8 + h) * 2 + dir;
    const float* GUp = F.GU + (size_t)bhd * 8448; const float* GBp = F.GB + (size_t)bhd * 8448; const float* GSp = F.GS + (size_t)bhd * 132;
    float nu = 0.f, nb = 0.f, n_um, n_be;
    float c_mx, c_a0, c_be;
#define ML_ROWBASE(ci_, RB, LAT) const int _ci = (ci_); const bool LAT = _ci >= 2; const int _ac = LAT ? (dir ? 63 - (_ci - 2) : (_ci - 2)) : (dir ? 1 - _ci : _ci); \
        const size_t RB = LAT ? ((size_t)b * SEQ + 128 * _ac) : ((size_t)b * CL + 128 * _ac);
#define ML_QFETCH(ci_) do { const int _cq = (ci_) >= 2 ? (ci_) : 2; ML_ROWBASE(_cq, _rb, _lat) const int _p = 16 * rb + li; const int _t = dir ? 127 - _p : _p; \
        const bf16* _qp = F.MQ + (_rb + _t) * 1024 + h * 128 + 8 * q; \
        _Pragma("unroll") for (int _k = 0; _k < 4; ++_k) qn[_k] = *(const GAS bf16x8*)(_qp + 32 * _k); } while (0)
#define ML_PREFETCH(ci_) do { ML_ROWBASE(ci_, _rb, _lat) \
        const bf16* _ks = (_lat ? F.MK : F.CMK) + h * 128; const bf16* _vs = (_lat ? F.MV : F.CMV) + h * 256 + vs * 64; \
        _Pragma("unroll") for (int _i = 0; _i < 4; ++_i) { const int _id = tid + 512 * _i, _row = _id >> 4, _cc = _id & 15; const int _t = dir ? 127 - _row : _row; kreg[_i] = *(const GAS v4u*)(_ks + (_rb + _t) * 1024 + 8 * _cc); } \
        _Pragma("unroll") for (int _i = 0; _i < 2; ++_i) { const int _id = tid + 512 * _i, _row = _id >> 3, _cc = _id & 7; const int _t = dir ? 127 - _row : _row; vreg[_i] = *(const GAS v4u*)(_vs + (_rb + _t) * 2048 + 8 * _cc); } \
    } while (0)
    { const int tid = (int)threadIdx.x; ML_PREFETCH(0);
      const float um0 = GSp[0]; c_be = GSp[1]; c_mx = fmaxf(0.f, um0); c_a0 = __expf(0.f - c_mx);
      if (tid < 128) { const float u = GUp[tid], bb = GBp[tid]; LAS float* A0 = (LAS float*)(lds + AR_OFF); A0[A_E / 4 + tid] = __expf(u - c_mx); A0[A_EM / 4 + tid] = __expf(-(bb + c_mx)); nu = GUp[128 + tid]; nb = GBp[128 + tid]; }
      n_um = GSp[2]; n_be = GSp[3]; }
    __syncthreads();
    for (int ci = 0; ci < 66; ++ci) {
        const bool lat = ci >= 2;
        const int ac = lat ? (dir ? 63 - (ci - 2) : (ci - 2)) : 0;
        int tid = (int)threadIdx.x; asm volatile("" : "+v"(tid));
        const int lane = tid & 63, li = lane & 15, q = lane >> 4;
        LAS unsigned char* Pw = lds + P_OFF + w * 16 * PST;
        LAS float* AR = (LAS float*)(lds + AR_OFF + (ci & 1) * AR_BUF);
        const int kbase = ldsbase + K_OFF + (4 * q + (li >> 2)) * KST + (16 * w + 4 * (li & 3)) * 2;
        const int vbase = ldsbase + V_OFF + (4 * q + (li >> 2)) * VST + (4 * (li & 3)) * 2;
#pragma unroll
        for (int i = 0; i < 4; ++i) { const int id = tid + 512 * i, row = id >> 4, cc = id & 15; const float e = AR[A_E / 4 + row]; const v4u kv = kreg[i]; v4u ke;
            ke.x = pg8::cvt_pk_bf16(bflo(kv.x) * e, bfhi(kv.x) * e); ke.y = pg8::cvt_pk_bf16(bflo(kv.y) * e, bfhi(kv.y) * e); ke.z = pg8::cvt_pk_bf16(bflo(kv.z) * e, bfhi(kv.z) * e); ke.w = pg8::cvt_pk_bf16(bflo(kv.w) * e, bfhi(kv.w) * e);
            *(LAS v4u*)(lds + K_OFF + row * KST + cc * 16) = ke; }
#pragma unroll
        for (int i = 0; i < 2; ++i) { const int id = tid + 512 * i, row = id >> 3, cc = id & 7; *(LAS v4u*)(lds + V_OFF + row * VST + cc * 16) = vreg[i]; }
        bf16x8 qf[4];
#pragma unroll
        for (int i = 0; i < 4; ++i) qf[i] = qn[i];
        asm volatile("s_waitcnt lgkmcnt(0)" ::: "memory"); __builtin_amdgcn_s_barrier(); asm volatile("" ::: "memory");
        const float bend = c_be, mx = c_mx, a0 = c_a0;
        if (ci + 1 < 66) {
            const float m0n = bend + mx, mxn = fmaxf(m0n, n_um);
            if (tid < 128) { LAS float* A1 = (LAS float*)(lds + AR_OFF + ((ci + 1) & 1) * AR_BUF); A1[A_E / 4 + tid] = __expf(nu - mxn); A1[A_EM / 4 + tid] = __expf(-(nb + mxn)); }
            c_mx = mxn; c_a0 = __expf(m0n - mxn); c_be = n_be;
        }
        { const int cn = ci + 1 < 66 ? ci + 1 : 65; ML_PREFETCH(cn); ML_QFETCH(cn); }
        { const int c2 = ci + 2 < 66 ? ci + 2 : 65; const int tq = tid & 127; nu = GUp[c2 * 128 + tq]; nb = GBp[c2 * 128 + tq]; const float* gsv = GSp + 2 * c2 + (tid >> 20); n_um = gsv[0]; n_be = gsv[1]; }
        f32x4 acc[5], dl[5];
#pragma unroll
        for (int i = 0; i < 5; ++i) { acc[i] = (f32x4){0.f, 0.f, 0.f, 0.f}; dl[i] = acc[i]; }
        const int prow = 16 * rb + li;
        f32x4 st[8];
#pragma unroll
        for (int i = 0; i < 8; ++i) st[i] = (f32x4){0.f, 0.f, 0.f, 0.f};
        if (lat) {
#define ML_LDK(dst, sb_) do { _Pragma("unroll") for (int ks = 0; ks < 4; ++ks) dst[ks] = *(const LAS bf16x8*)(lds + K_OFF + (16 * (sb_) + li) * KST + (32 * ks + 8 * q) * 2); } while (0)
#define ML_SBLK(cur, nxt, sb_) do { if ((sb_) <= rb) { if ((sb_) + 1 <= rb && (sb_) + 1 < 8) ML_LDK(nxt, (sb_) + 1); \
                _Pragma("unroll") for (int ks = 0; ks < 4; ++ks) st[sb_] = __builtin_amdgcn_mfma_f32_16x16x32_bf16(cur[ks], qf[ks], st[sb_], 0, 0, 0); \
                if ((sb_) == rb) { _Pragma("unroll") for (int r = 0; r < 4; ++r) st[sb_][r] = (4 * q + r <= li) ? st[sb_][r] : 0.f; } } } while (0)
            { bf16x8 kfA[4], kfB[4]; ML_LDK(kfA, 0);
              ML_SBLK(kfA, kfB, 0); ML_SBLK(kfB, kfA, 1); ML_SBLK(kfA, kfB, 2); ML_SBLK(kfB, kfA, 3); ML_SBLK(kfA, kfB, 4); ML_SBLK(kfB, kfA, 5); ML_SBLK(kfA, kfB, 6); ML_SBLK(kfB, kfA, 7); }
#undef ML_SBLK
#undef ML_LDK
#define ML_LDC(dst, ks_) do { _Pragma("unroll") for (int vb = 0; vb < 5; ++vb) dst[vb] = *(const LAS bf16x8*)(lds + CT_OFF + (16 * vb + li) * CST + (32 * (ks_) + 8 * q) * 2); } while (0)
#define ML_QCM(src, ks_) do { _Pragma("unroll") for (int vb = 0; vb < 5; ++vb) acc[vb] = __builtin_amdgcn_mfma_f32_16x16x32_bf16(src[vb], qf[ks_], acc[vb], 0, 0, 0); } while (0)
            { bf16x8 cA[5], cB[5]; ML_LDC(cA, 0); ML_LDC(cB, 1); ML_QCM(cA, 0); ML_LDC(cA, 2); ML_QCM(cB, 1); ML_LDC(cB, 3); ML_QCM(cA, 2); ML_QCM(cB, 3); }
#undef ML_LDC
#undef ML_QCM
#pragma unroll
            for (int vb = 0; vb < 5; ++vb) acc[vb] = acc[vb] * a0;
        }
#define ML_KLOAD(S, KS) do { \
        S##a0 = trr<(32 * KS) * VST + 0>(vbase);  S##a1 = trr<(32 * KS + 16) * VST + 0>(vbase);  S##b0 = trr<(32 * KS) * VST + 32>(vbase); S##b1 = trr<(32 * KS + 16) * VST + 32>(vbase); \
        S##c0 = trr<(32 * KS) * VST + 64>(vbase); S##c1 = trr<(32 * KS + 16) * VST + 64>(vbase); S##d0 = trr<(32 * KS) * VST + 96>(vbase); S##d1 = trr<(32 * KS + 16) * VST + 96>(vbase); \
        S##o0 = trr<(32 * KS) * VST + 128>(vbase); S##o1 = trr<(32 * KS + 16) * VST + 128>(vbase); \
        S##k0 = trr<(32 * KS) * KST>(kbase); S##k1 = trr<(32 * KS + 16) * KST>(kbase); } while (0)
#define ML_KCOMP(S, KS) do { \
        const bf16x8 v0 = ML_PK(S##a0, S##a1), v1 = ML_PK(S##b0, S##b1), v2 = ML_PK(S##c0, S##c1), v3 = ML_PK(S##d0, S##d1), v4 = ML_PK(S##o0, S##o1); \
        const bf16x8 kte = ML_PK(S##k0, S##k1); \
        if (lat && KS <= (rb >> 1)) { v4u pw; pw.x = pg8::cvt_pk_bf16(st[2 * KS][0], st[2 * KS][1]); pw.y = pg8::cvt_pk_bf16(st[2 * KS][2], st[2 * KS][3]); pw.z = pg8::cvt_pk_bf16(st[2 * KS + 1][0], st[2 * KS + 1][1]); pw.w = pg8::cvt_pk_bf16(st[2 * KS + 1][2], st[2 * KS + 1][3]); \
            const bf16x8 pf = __builtin_bit_cast(bf16x8, pw); \
            acc[0] = __builtin_amdgcn_mfma_f32_16x16x32_bf16(v0, pf, acc[0], 0, 0, 0); acc[1] = __builtin_amdgcn_mfma_f32_16x16x32_bf16(v1, pf, acc[1], 0, 0, 0); \
            acc[2] = __builtin_amdgcn_mfma_f32_16x16x32_bf16(v2, pf, acc[2], 0, 0, 0); acc[3] = __builtin_amdgcn_mfma_f32_16x16x32_bf16(v3, pf, acc[3], 0, 0, 0); \
            acc[4] = __builtin_amdgcn_mfma_f32_16x16x32_bf16(v4, pf, acc[4], 0, 0, 0); } \
        dl[0] = __builtin_amdgcn_mfma_f32_16x16x32_bf16(kte, v0, dl[0], 0, 0, 0); dl[1] = __builtin_amdgcn_mfma_f32_16x16x32_bf16(kte, v1, dl[1], 0, 0, 0); \
        dl[2] = __builtin_amdgcn_mfma_f32_16x16x32_bf16(kte, v2, dl[2], 0, 0, 0); dl[3] = __builtin_amdgcn_mfma_f32_16x16x32_bf16(kte, v3, dl[3], 0, 0, 0); \
        dl[4] = __builtin_amdgcn_mfma_f32_16x16x32_bf16(kte, v4, dl[4], 0, 0, 0); } while (0)
#define ML_WAIT12() do { asm volatile("s_waitcnt lgkmcnt(12)" ::: "memory"); __builtin_amdgcn_sched_barrier(0); } while (0)
#define ML_WAIT0() do { asm volatile("s_waitcnt lgkmcnt(0)" ::: "memory"); __builtin_amdgcn_sched_barrier(0); } while (0)
        { s16x4 Aa0, Aa1, Ab0, Ab1, Ac0, Ac1, Ad0, Ad1, Ao0, Ao1, Ak0, Ak1, Ba0, Ba1, Bb0, Bb1, Bc0, Bc1, Bd0, Bd1, Bo0, Bo1, Bk0, Bk1;
          ML_KLOAD(A, 0); ML_KLOAD(B, 1); ML_WAIT12(); ML_KCOMP(A, 0);
          asm volatile("" ::: "memory"); ML_KLOAD(A, 2); ML_WAIT12(); ML_KCOMP(B, 1);
          asm volatile("" ::: "memory"); ML_KLOAD(B, 3); ML_WAIT12(); ML_KCOMP(A, 2);
          ML_WAIT0(); ML_KCOMP(B, 3); }
#undef ML_KLOAD
#undef ML_KCOMP
#undef ML_WAIT12
#undef ML_WAIT0
        if (lat) {
            const float em = AR[A_EM / 4 + prow];
            const float den = __shfl(acc[4][0], li);
            const float inv = 1.0f / fmaxf(fabsf(den), em);
            asm volatile("s_waitcnt lgkmcnt(0)" ::: "memory");
#pragma unroll
            for (int vb = 0; vb < 4; ++vb) { const f32x4 o = acc[vb] * inv; v2u wv; wv.x = pg8::cvt_pk_bf16(o[0], o[1]); wv.y = pg8::cvt_pk_bf16(o[2], o[3]);
                *(LAS v2u*)(Pw + li * VST + (16 * vb + 4 * q) * 2) = wv; }
            asm volatile("s_waitcnt lgkmcnt(0)" ::: "memory");
            const size_t rb0 = (size_t)b * SEQ + 128 * ac;
#pragma unroll
            for (int i = 0; i < 2; ++i) { const int idx = lane + 64 * i, row = idx >> 3, ch = idx & 7; const v4u ov = *(const LAS v4u*)(Pw + row * VST + ch * 16);
                const int p = 16 * rb + row; const int t = dir ? 127 - p : p; *(GAS v4u*)(Hd + (rb0 + t) * 2048 + h * 256 + vs * 64 + 8 * ch) = ov; }
        }
#pragma unroll
        for (int vb = 0; vb < 5; ++vb) Cst[vb] = Cst[vb] * a0 + dl[vb];
        asm volatile("s_waitcnt lgkmcnt(0)" ::: "memory"); __builtin_amdgcn_s_barrier(); asm volatile("" ::: "memory");
#pragma unroll
        for (int vb = 0; vb < 5; ++vb) { v2u wv; wv.x = pg8::cvt_pk_bf16(Cst[vb][0], Cst[vb][1]); wv.y = pg8::cvt_pk_bf16(Cst[vb][2], Cst[vb][3]); *(LAS v2u*)(lds + CT_OFF + (16 * vb + li) * CST + (16 * w + 4 * q) * 2) = wv; }
    }
    __syncthreads();
#undef ML_PREFETCH
#undef ML_QFETCH
#undef ML_ROWBASE
}

constexpr int WKST = 272, WVST = 272, WCST = 272;
constexpr int WK_OFF = 0, WV_OFF = WK_OFF + 128 * WKST, WCT_OFF = WV_OFF + 128 * WVST, WP_OFF = WCT_OFF + 144 * WCST, WAR_OFF = WP_OFF + 8 * 2304;
constexpr int MLW_LDS = WAR_OFF + 2 * AR_BUF;
static_assert(MLW_LDS <= 131072, "wide mLSTM LDS map");
__device__ __forceinline__ void mlstm_unit_wide(Frame& F, int unit, unsigned char* ldsg) {
    const int vs = unit & 1, dir = (unit >> 1) & 1, h = (unit >> 2) & 7, b = unit >> 5;
    const int w = F.wave, rb = (w < 4) ? w : 11 - w;
    LAS unsigned char* lds = F.lds;
    const int ldsbase = (int)(uintptr_t)ldsg;
    bf16* Hd = dir ? F.H1 : F.H0;
    f32x4 Cst[9];
#pragma unroll
    for (int i = 0; i < 9; ++i) Cst[i] = (f32x4){0.f, 0.f, 0.f, 0.f};
    for (int i = (int)threadIdx.x; i < 144 * WCST / 4; i += 512) ((LAS unsigned*)(lds + WCT_OFF))[i] = 0u;
    if ((int)threadIdx.x < 128) *(LAS v4u*)(lds + WV_OFF + (int)threadIdx.x * WVST + 256) = (v4u){0x3f80u, 0u, 0u, 0u};
    v4u kreg[4], vreg[4]; bf16x8 qn[4];
#pragma unroll
    for (int i = 0; i < 4; ++i) qn[i] = (bf16x8){0, 0, 0, 0, 0, 0, 0, 0};
    const int bhd = (b * 8 + h) * 2 + dir;
    const float* GUp = F.GU + (size_t)bhd * 8448; const float* GBp = F.GB + (size_t)bhd * 8448; const float* GSp = F.GS + (size_t)bhd * 132;
    float nu = 0.f, nb = 0.f, n_um, n_be, c_mx, c_a0, c_be;
#define MLW_ROWBASE(ci_, RB, LAT) const int _ci = (ci_); const bool LAT = _ci >= 2; const int _ac = LAT ? (dir ? 63 - (_ci - 2) : (_ci - 2)) : (dir ? 1 - _ci : _ci); \
        const size_t RB = LAT ? ((size_t)b * SEQ + 128 * _ac) : ((size_t)b * CL + 128 * _ac);
#define MLW_QFETCH(ci_) do { const int _cq = (ci_) >= 2 ? (ci_) : 2; MLW_ROWBASE(_cq, _rb, _lat) const int _p = 16 * rb + li; const int _t = dir ? 127 - _p : _p; \
        const bf16* _qp = F.MQ + (_rb + _t) * 1024 + h * 128 + 8 * q; \
        _Pragma("unroll") for (int _k = 0; _k < 4; ++_k) qn[_k] = *(const GAS bf16x8*)(_qp + 32 * _k); } while (0)
#define MLW_PREFETCH(ci_) do { MLW_ROWBASE(ci_, _rb, _lat) \
        const bf16* _ks = (_lat ? F.MK : F.CMK) + h * 128; const bf16* _vs = (_lat ? F.MV : F.CMV) + h * 256 + vs * 128; \
        _Pragma("unroll") for (int _i = 0; _i < 4; ++_i) { const int _id = tid + 512 * _i, _row = _id >> 4, _cc = _id & 15; const int _t = dir ? 127 - _row : _row; \
            kreg[_i] = *(const GAS v4u*)(_ks + (_rb + _t) * 1024 + 8 * _cc); vreg[_i] = *(const GAS v4u*)(_vs + (_rb + _t) * 2048 + 8 * _cc); } \
    } while (0)
    { const int tid = (int)threadIdx.x; MLW_PREFETCH(0);
      const float um0 = GSp[0]; c_be = GSp[1]; c_mx = fmaxf(0.f, um0); c_a0 = __expf(0.f - c_mx);
      if (tid < 128) { const float u = GUp[tid], bb = GBp[tid]; LAS float* A0 = (LAS float*)(lds + WAR_OFF); A0[A_E / 4 + tid] = __expf(u - c_mx); A0[A_EM / 4 + tid] = __expf(-(bb + c_mx)); nu = GUp[128 + tid]; nb = GBp[128 + tid]; }
      n_um = GSp[2]; n_be = GSp[3]; }
    __syncthreads();
    float en[4];
    { const int tid = (int)threadIdx.x; const LAS float* A0 = (const LAS float*)(lds + WAR_OFF);
#pragma unroll
      for (int i = 0; i < 4; ++i) en[i] = A0[A_E / 4 + ((tid + 512 * i) >> 4)]; }
    for (int ci = 0; ci < 66; ++ci) {
        const bool lat = ci >= 2;
        const int ac = lat ? (dir ? 63 - (ci - 2) : (ci - 2)) : 0;
        int tid = (int)threadIdx.x; asm volatile("" : "+v"(tid));
        const int lane = tid & 63, li = lane & 15, q = lane >> 4;
        LAS unsigned char* Pw = lds + WP_OFF + w * 2304;
        LAS float* AR = (LAS float*)(lds + WAR_OFF + (ci & 1) * AR_BUF);
        const int kbase = ldsbase + WK_OFF + (4 * q + (li >> 2)) * WKST + (16 * w + 4 * (li & 3)) * 2;
        const int vbase = ldsbase + WV_OFF + (4 * q + (li >> 2)) * WVST + (4 * (li & 3)) * 2;
#pragma unroll
        for (int i = 0; i < 4; ++i) { const int id = tid + 512 * i, row = id >> 4, cc = id & 15; const float e = en[i]; const v4u kv = kreg[i]; v4u ke;
            ke.x = pg8::cvt_pk_bf16(bflo(kv.x) * e, bfhi(kv.x) * e); ke.y = pg8::cvt_pk_bf16(bflo(kv.y) * e, bfhi(kv.y) * e); ke.z = pg8::cvt_pk_bf16(bflo(kv.z) * e, bfhi(kv.z) * e); ke.w = pg8::cvt_pk_bf16(bflo(kv.w) * e, bfhi(kv.w) * e);
            *(LAS v4u*)(lds + WK_OFF + row * WKST + cc * 16) = ke; *(LAS v4u*)(lds + WV_OFF + row * WVST + cc * 16) = vreg[i]; }
        bf16x8 qf[4];
#pragma unroll
        for (int i = 0; i < 4; ++i) qf[i] = qn[i];
        asm volatile("s_waitcnt lgkmcnt(0)" ::: "memory"); __builtin_amdgcn_s_barrier(); asm volatile("" ::: "memory");
        const float bend = c_be, mx = c_mx, a0 = c_a0;
        if (ci + 1 < 66) {
            const float m0n = bend + mx, mxn = fmaxf(m0n, n_um);
            if (tid < 128) { LAS float* A1 = (LAS float*)(lds + WAR_OFF + ((ci + 1) & 1) * AR_BUF); A1[A_E / 4 + tid] = __expf(nu - mxn); A1[A_EM / 4 + tid] = __expf(-(nb + mxn)); }
            c_mx = mxn; c_a0 = __expf(m0n - mxn); c_be = n_be;
        }
        { const int cn = ci + 1 < 66 ? ci + 1 : 65; MLW_PREFETCH(cn); MLW_QFETCH(cn); }
        { const int c2 = ci + 2 < 66 ? ci + 2 : 65; const int tq = tid & 127; nu = GUp[c2 * 128 + tq]; nb = GBp[c2 * 128 + tq]; const float* gsv = GSp + 2 * c2 + (tid >> 20); n_um = gsv[0]; n_be = gsv[1]; }
        f32x4 acc[9];
#pragma unroll
        for (int i = 0; i < 9; ++i) acc[i] = (f32x4){0.f, 0.f, 0.f, 0.f};
        const int prow = 16 * rb + li;
        f32x4 st[8];
#pragma unroll
        for (int i = 0; i < 8; ++i) st[i] = (f32x4){0.f, 0.f, 0.f, 0.f};
        if (lat) {
#define MLW_SBLK(sb_) do { if ((sb_) <= rb) { const int kb_ = ldsbase + WK_OFF + (16 * (sb_) + li) * WKST + 16 * q; \
                f32x4 k0_ = ldr128<0>(kb_), k1_ = ldr128<64>(kb_), k2_ = ldr128<128>(kb_), k3_ = ldr128<192>(kb_); \
                asm volatile("s_waitcnt lgkmcnt(3)" : "+v"(k0_) :: "memory"); st[sb_] = __builtin_amdgcn_mfma_f32_16x16x32_bf16(__builtin_bit_cast(bf16x8, k0_), qf[0], (f32x4){0.f, 0.f, 0.f, 0.f}, 0, 0, 0); \
                asm volatile("s_waitcnt lgkmcnt(2)" : "+v"(k1_) :: "memory"); st[sb_] = __builtin_amdgcn_mfma_f32_16x16x32_bf16(__builtin_bit_cast(bf16x8, k1_), qf[1], st[sb_], 0, 0, 0); \
                asm volatile("s_waitcnt lgkmcnt(1)" : "+v"(k2_) :: "memory"); st[sb_] = __builtin_amdgcn_mfma_f32_16x16x32_bf16(__builtin_bit_cast(bf16x8, k2_), qf[2], st[sb_], 0, 0, 0); \
                asm volatile("s_waitcnt lgkmcnt(0)" : "+v"(k3_) :: "memory"); st[sb_] = __builtin_amdgcn_mfma_f32_16x16x32_bf16(__builtin_bit_cast(bf16x8, k3_), qf[3], st[sb_], 0, 0, 0); \
                if ((sb_) == rb) { _Pragma("unroll") for (int r = 0; r < 4; ++r) st[sb_][r] = (4 * q + r <= li) ? st[sb_][r] : 0.f; } } } while (0)
            MLW_SBLK(0); MLW_SBLK(1); MLW_SBLK(2); MLW_SBLK(3); MLW_SBLK(4); MLW_SBLK(5); MLW_SBLK(6); MLW_SBLK(7);
#undef MLW_SBLK
#define MLW_WAITN(n) do { asm volatile("s_waitcnt lgkmcnt(" #n ")" ::: "memory"); __builtin_amdgcn_sched_barrier(0); } while (0)
            { const int cbase = ldsbase + WCT_OFF + li * WCST + 16 * q; f32x4 qc0, qc1, qc2, qc3; const f32x4 qcz = (f32x4){0.f, 0.f, 0.f, 0.f};
#define QC_OFF(S) ((16 * ((S) % 9)) * WCST + 64 * ((S) / 9))
#define QC_MM(SRC, S) acc[(S) % 9] = __builtin_amdgcn_mfma_f32_16x16x32_bf16(__builtin_bit_cast(bf16x8, SRC), qf[(S) / 9], (S) < 9 ? qcz : acc[(S) % 9], 0, 0, 0)
              qc0 = ldr128<QC_OFF(0)>(cbase); qc1 = ldr128<QC_OFF(1)>(cbase); qc2 = ldr128<QC_OFF(2)>(cbase); qc3 = ldr128<QC_OFF(3)>(cbase);
              MLW_WAITN(3); QC_MM(qc0, 0); qc0 = ldr128<QC_OFF(4)>(cbase);
              MLW_WAITN(3); QC_MM(qc1, 1); qc1 = ldr128<QC_OFF(5)>(cbase);
              MLW_WAITN(3); QC_MM(qc2, 2); qc2 = ldr128<QC_OFF(6)>(cbase);
              MLW_WAITN(3); QC_MM(qc3, 3); qc3 = ldr128<QC_OFF(7)>(cbase);
              MLW_WAITN(3); QC_MM(qc0, 4); qc0 = ldr128<QC_OFF(8)>(cbase);
              MLW_WAITN(3); QC_MM(qc1, 5); qc1 = ldr128<QC_OFF(9)>(cbase);
              MLW_WAITN(3); QC_MM(qc2, 6); qc2 = ldr128<QC_OFF(10)>(cbase);
              MLW_WAITN(3); QC_MM(qc3, 7); qc3 = ldr128<QC_OFF(11)>(cbase);
              MLW_WAITN(3); QC_MM(qc0, 8); qc0 = ldr128<QC_OFF(12)>(cbase);
              MLW_WAITN(3); QC_MM(qc1, 9); qc1 = ldr128<QC_OFF(13)>(cbase);
              MLW_WAITN(3); QC_MM(qc2, 10); qc2 = ldr128<QC_OFF(14)>(cbase);
              MLW_WAITN(3); QC_MM(qc3, 11); qc3 = ldr128<QC_OFF(15)>(cbase);
              MLW_WAITN(3); QC_MM(qc0, 12); qc0 = ldr128<QC_OFF(16)>(cbase);
              MLW_WAITN(3); QC_MM(qc1, 13); qc1 = ldr128<QC_OFF(17)>(cbase);
              MLW_WAITN(3); QC_MM(qc2, 14); qc2 = ldr128<QC_OFF(18)>(cbase);
              MLW_WAITN(3); QC_MM(qc3, 15); qc3 = ldr128<QC_OFF(19)>(cbase);
              MLW_WAITN(3); QC_MM(qc0, 16); qc0 = ldr128<QC_OFF(20)>(cbase);
              MLW_WAITN(3); QC_MM(qc1, 17); qc1 = ldr128<QC_OFF(21)>(cbase);
              MLW_WAITN(3); QC_MM(qc2, 18); qc2 = ldr128<QC_OFF(22)>(cbase);
              MLW_WAITN(3); QC_MM(qc3, 19); qc3 = ldr128<QC_OFF(23)>(cbase);
              MLW_WAITN(3); QC_MM(qc0, 20); qc0 = ldr128<QC_OFF(24)>(cbase);
              MLW_WAITN(3); QC_MM(qc1, 21); qc1 = ldr128<QC_OFF(25)>(cbase);
              MLW_WAITN(3); QC_MM(qc2, 22); qc2 = ldr128<QC_OFF(26)>(cbase);
              MLW_WAITN(3); QC_MM(qc3, 23); qc3 = ldr128<QC_OFF(27)>(cbase);
              MLW_WAITN(3); QC_MM(qc0, 24); qc0 = ldr128<QC_OFF(28)>(cbase);
              MLW_WAITN(3); QC_MM(qc1, 25); qc1 = ldr128<QC_OFF(29)>(cbase);
              MLW_WAITN(3); QC_MM(qc2, 26); qc2 = ldr128<QC_OFF(30)>(cbase);
              MLW_WAITN(3); QC_MM(qc3, 27); qc3 = ldr128<QC_OFF(31)>(cbase);
              MLW_WAITN(3); QC_MM(qc0, 28); qc0 = ldr128<QC_OFF(32)>(cbase);
              MLW_WAITN(3); QC_MM(qc1, 29); qc1 = ldr128<QC_OFF(33)>(cbase);
              MLW_WAITN(3); QC_MM(qc2, 30); qc2 = ldr128<QC_OFF(34)>(cbase);
              MLW_WAITN(3); QC_MM(qc3, 31); qc3 = ldr128<QC_OFF(35)>(cbase);
              MLW_WAITN(3); QC_MM(qc0, 32);
              MLW_WAITN(2); QC_MM(qc1, 33);
              MLW_WAITN(1); QC_MM(qc2, 34);
              MLW_WAITN(0); QC_MM(qc3, 35);
#undef QC_OFF
#undef QC_MM
            }
#pragma unroll
            for (int vb = 0; vb < 9; ++vb) acc[vb] = acc[vb] * a0;
        }
#define MLW_PF(KS) ({ v4u pw; pw.x = pg8::cvt_pk_bf16(st[2 * KS][0], st[2 * KS][1]); pw.y = pg8::cvt_pk_bf16(st[2 * KS][2], st[2 * KS][3]); pw.z = pg8::cvt_pk_bf16(st[2 * KS + 1][0], st[2 * KS + 1][1]); pw.w = pg8::cvt_pk_bf16(st[2 * KS + 1][2], st[2 * KS + 1][3]); __builtin_bit_cast(bf16x8, pw); })
#define MLW_WAIT0() do { asm volatile("s_waitcnt lgkmcnt(0)" ::: "memory"); __builtin_amdgcn_sched_barrier(0); } while (0)
#define MLW_LOAD5(S, KS, BO) do { \
        S##a0 = trr<(32 * KS) * WVST + BO + 0>(vbase);  S##a1 = trr<(32 * KS + 16) * WVST + BO + 0>(vbase);  S##b0 = trr<(32 * KS) * WVST + BO + 32>(vbase); S##b1 = trr<(32 * KS + 16) * WVST + BO + 32>(vbase); \
        S##c0 = trr<(32 * KS) * WVST + BO + 64>(vbase); S##c1 = trr<(32 * KS + 16) * WVST + BO + 64>(vbase); S##d0 = trr<(32 * KS) * WVST + BO + 96>(vbase); S##d1 = trr<(32 * KS + 16) * WVST + BO + 96>(vbase); \
        S##o0 = trr<(32 * KS) * WVST + BO + 128>(vbase); S##o1 = trr<(32 * KS + 16) * WVST + BO + 128>(vbase); \
        S##k0 = trr<(32 * KS) * WKST>(kbase); S##k1 = trr<(32 * KS + 16) * WKST>(kbase); } while (0)
#define MLW_LOAD4(S, KS, BO) do { \
        S##a0 = trr<(32 * KS) * WVST + BO + 0>(vbase);  S##a1 = trr<(32 * KS + 16) * WVST + BO + 0>(vbase);  S##b0 = trr<(32 * KS) * WVST + BO + 32>(vbase); S##b1 = trr<(32 * KS + 16) * WVST + BO + 32>(vbase); \
        S##c0 = trr<(32 * KS) * WVST + BO + 64>(vbase); S##c1 = trr<(32 * KS + 16) * WVST + BO + 64>(vbase); S##d0 = trr<(32 * KS) * WVST + BO + 96>(vbase); S##d1 = trr<(32 * KS + 16) * WVST + BO + 96>(vbase); \
        S##k0 = trr<(32 * KS) * WKST>(kbase); S##k1 = trr<(32 * KS + 16) * WKST>(kbase); } while (0)
#define MLW_COMP(S, KS, NB, A0) do { \
        const bf16x8 v0 = ML_PK(S##a0, S##a1), v1 = ML_PK(S##b0, S##b1), v2 = ML_PK(S##c0, S##c1), v3 = ML_PK(S##d0, S##d1), v4 = ML_PK(S##o0, S##o1), kte = ML_PK(S##k0, S##k1); \
        if (lat && KS <= (rb >> 1)) { const bf16x8 pf = MLW_PF(KS); \
            acc[A0 + 0] = __builtin_amdgcn_mfma_f32_16x16x32_bf16(v0, pf, acc[A0 + 0], 0, 0, 0); acc[A0 + 1] = __builtin_amdgcn_mfma_f32_16x16x32_bf16(v1, pf, acc[A0 + 1], 0, 0, 0); \
            acc[A0 + 2] = __builtin_amdgcn_mfma_f32_16x16x32_bf16(v2, pf, acc[A0 + 2], 0, 0, 0); acc[A0 + 3] = __builtin_amdgcn_mfma_f32_16x16x32_bf16(v3, pf, acc[A0 + 3], 0, 0, 0); \
            if (NB == 5) acc[A0 + NB - 1] = __builtin_amdgcn_mfma_f32_16x16x32_bf16(v4, pf, acc[A0 + NB - 1], 0, 0, 0); } \
        dl[0] = __builtin_amdgcn_mfma_f32_16x16x32_bf16(kte, v0, dl[0], 0, 0, 0); dl[1] = __builtin_amdgcn_mfma_f32_16x16x32_bf16(kte, v1, dl[1], 0, 0, 0); \
        dl[2] = __builtin_amdgcn_mfma_f32_16x16x32_bf16(kte, v2, dl[2], 0, 0, 0); dl[3] = __builtin_amdgcn_mfma_f32_16x16x32_bf16(kte, v3, dl[3], 0, 0, 0); \
        if (NB == 5) dl[4] = __builtin_amdgcn_mfma_f32_16x16x32_bf16(kte, v4, dl[4], 0, 0, 0); } while (0)
        { s16x4 Aa0, Aa1, Ab0, Ab1, Ac0, Ac1, Ad0, Ad1, Ao0 = (s16x4){0, 0, 0, 0}, Ao1 = Ao0, Ak0, Ak1, Ba0, Ba1, Bb0, Bb1, Bc0, Bc1, Bd0, Bd1, Bo0 = Ao0, Bo1 = Ao0, Bk0, Bk1;
          f32x4 dl[5];
#pragma unroll
          for (int i = 0; i < 5; ++i) dl[i] = (f32x4){0.f, 0.f, 0.f, 0.f};
          MLW_LOAD5(A, 0, 0); MLW_LOAD5(B, 1, 0); MLW_WAITN(12); MLW_COMP(A, 0, 5, 0);
          asm volatile("" ::: "memory"); MLW_LOAD5(A, 2, 0); MLW_WAITN(12); MLW_COMP(B, 1, 5, 0);
          asm volatile("" ::: "memory"); MLW_LOAD5(B, 3, 0); MLW_WAITN(12); MLW_COMP(A, 2, 5, 0);
          asm volatile("" ::: "memory"); MLW_LOAD4(A, 0, 160); MLW_WAITN(10); MLW_COMP(B, 3, 5, 0);
#pragma unroll
          for (int vb = 0; vb < 5; ++vb) { Cst[vb] = Cst[vb] * a0 + dl[vb]; dl[vb] = (f32x4){0.f, 0.f, 0.f, 0.f}; }
          asm volatile("" ::: "memory"); MLW_LOAD4(B, 1, 160); MLW_WAITN(10); MLW_COMP(A, 0, 4, 5);
          asm volatile("" ::: "memory"); MLW_LOAD4(A, 2, 160); MLW_WAITN(10); MLW_COMP(B, 1, 4, 5);
          asm volatile("" ::: "memory"); MLW_LOAD4(B, 3, 160); MLW_WAITN(10); MLW_COMP(A, 2, 4, 5);
          MLW_WAITN(0); MLW_COMP(B, 3, 4, 5);
#pragma unroll
          for (int vb = 0; vb < 4; ++vb) Cst[5 + vb] = Cst[5 + vb] * a0 + dl[vb]; }
#undef MLW_LOAD5
#undef MLW_LOAD4
#undef MLW_COMP
#undef MLW_WAITN
#undef MLW_PF
#undef MLW_WAIT0
        if (lat) {
            const float em = AR[A_EM / 4 + prow];
            const float den = __shfl(acc[8][0], li);
            const float inv = 1.0f / fmaxf(fabsf(den), em);
            const size_t rb0 = (size_t)b * SEQ + 128 * ac;
#pragma unroll
            for (int hf = 0; hf < 2; ++hf) {
#pragma unroll
                for (int vb = 0; vb < 4; ++vb) { const f32x4 o = acc[4 * hf + vb] * inv; v2u wv; wv.x = pg8::cvt_pk_bf16(o[0], o[1]); wv.y = pg8::cvt_pk_bf16(o[2], o[3]);
                    *(LAS v2u*)(Pw + li * 144 + (16 * vb + 4 * q) * 2) = wv; }
                asm volatile("s_waitcnt lgkmcnt(0)" ::: "memory");
#pragma unroll
                for (int i = 0; i < 2; ++i) { const int idx = lane + 64 * i, row = idx >> 3, ch = idx & 7; const v4u ov = *(const LAS v4u*)(Pw + row * 144 + ch * 16);
                    const int p = 16 * rb + row; const int t = dir ? 127 - p : p; *(GAS v4u*)(Hd + (rb0 + t) * 2048 + h * 256 + vs * 128 + hf * 64 + 8 * ch) = ov; }
                asm volatile("s_waitcnt lgkmcnt(0)" ::: "memory");
            }
        }
        asm volatile("s_waitcnt lgkmcnt(0)" ::: "memory"); __builtin_amdgcn_s_barrier(); asm volatile("" ::: "memory");
        { const LAS float* AN = (const LAS float*)(lds + WAR_OFF + ((ci + 1) & 1) * AR_BUF);
#pragma unroll
          for (int i = 0; i < 4; ++i) en[i] = AN[A_E / 4 + ((tid + 512 * i) >> 4)]; }
#pragma unroll
        for (int vb = 0; vb < 9; ++vb) { v2u wv; wv.x = pg8::cvt_pk_bf16(Cst[vb][0], Cst[vb][1]); wv.y = pg8::cvt_pk_bf16(Cst[vb][2], Cst[vb][3]); *(LAS v2u*)(lds + WCT_OFF + (16 * vb + li) * WCST + (16 * w + 4 * q) * 2) = wv; }
    }
    __syncthreads();
#undef MLW_PREFETCH
#undef MLW_QFETCH
#undef MLW_ROWBASE
}
#undef ML_PK
}
__device__ __forceinline__ void phase_mem(Frame& F) {
    const int gw = F.bid * NWAVES + F.wave, NGW = F.G * NWAVES; const int lane = (int)(threadIdx.x & 63);
    f32x4 g[4][2];
#pragma unroll
    for (int j = 0; j < 4; ++j) { g[j][0] = *(const GAS f32x4*)(F.mlstm_norm_g + 8 * (64 * j + lane)); g[j][1] = *(const GAS f32x4*)(F.mlstm_norm_g + 8 * (64 * j + lane) + 4); }
    if (gw >= MLAT) return;
    v4u na[4], nc[4], nm[4];
    { const GAS v4u* p0 = (const GAS v4u*)(F.H0 + (size_t)gw * 2048) + lane; const GAS v4u* p1 = (const GAS v4u*)(F.H1 + (size_t)gw * 2048) + lane; const GAS v4u* pm = (const GAS v4u*)(F.AM + (size_t)gw * 4096 + 2048) + lane;
#pragma unroll
      for (int j = 0; j < 4; ++j) { na[j] = p0[64 * j]; nc[j] = p1[64 * j]; nm[j] = pm[64 * j]; } }
    for (int row = gw; row < MLAT; row += NGW) {
        v4u a[4], c[4], mo[4];
#pragma unroll
        for (int j = 0; j < 4; ++j) { a[j] = na[j]; c[j] = nc[j]; mo[j] = nm[j]; }
        if (row + NGW < MLAT) { const int rn = row + NGW; const GAS v4u* p0 = (const GAS v4u*)(F.H0 + (size_t)rn * 2048) + lane; const GAS v4u* p1 = (const GAS v4u*)(F.H1 + (size_t)rn * 2048) + lane; const GAS v4u* pm = (const GAS v4u*)(F.AM + (size_t)rn * 4096 + 2048) + lane;
#pragma unroll
            for (int j = 0; j < 4; ++j) { na[j] = p0[64 * j]; nc[j] = p1[64 * j]; nm[j] = pm[64 * j]; } }
        GAS v4u* po = (GAS v4u*)(F.AM + (size_t)row * 4096 + 2048) + lane;
#pragma unroll
        for (int j = 0; j < 4; ++j) { float hv[8]; float ss = 0.f;
#pragma unroll
            for (int e = 0; e < 4; ++e) { const float lo = bflo(a[j][e]) + bflo(c[j][e]), hi = bfhi(a[j][e]) + bfhi(c[j][e]); hv[2 * e] = lo; hv[2 * e + 1] = hi; ss += lo * lo + hi * hi; }
            const float hs = half_sums_dpp(ss);
            const float s_lo = __builtin_bit_cast(float, __builtin_amdgcn_readlane(__builtin_bit_cast(int, hs), 31)), s_hi = __builtin_bit_cast(float, __builtin_amdgcn_readlane(__builtin_bit_cast(int, hs), 63));
            const float r = __builtin_amdgcn_rsqf(((lane & 32) ? s_hi : s_lo) * (1.0f / 256.0f) + NORM_EPS);
            const float gg[8] = {g[j][0].x, g[j][0].y, g[j][0].z, g[j][0].w, g[j][1].x, g[j][1].y, g[j][1].z, g[j][1].w};
            v4u o;
#pragma unroll
            for (int e = 0; e < 4; ++e) { const float x0 = sigmoidf_(bflo(mo[j][e])) * hv[2 * e] * r * gg[2 * e], x1 = sigmoidf_(bfhi(mo[j][e])) * hv[2 * e + 1] * r * gg[2 * e + 1]; o[e] = pg8::cvt_pk_bf16(x0, x1); }
            po[64 * j] = o; }
    }
}
__device__ __forceinline__ void phase_final_norm(Frame& F) {
    const int gw = F.bid * NWAVES + F.wave, NGW = F.G * NWAVES; const int lane = (int)(threadIdx.x & 63);
    f32x4 g[4][2];
#pragma unroll
    for (int j = 0; j < 4; ++j) { g[j][0] = *(const GAS f32x4*)(F.final_norm_g + 8 * (64 * j + lane)); g[j][1] = *(const GAS f32x4*)(F.final_norm_g + 8 * (64 * j + lane) + 4); }
    if (gw >= MLAT) return;
    v4u nx[4];
    { const GAS v4u* xr = (const GAS v4u*)(F.H + (size_t)gw * D) + lane;
#pragma unroll
      for (int j = 0; j < 4; ++j) nx[j] = xr[64 * j]; }
    for (int row = gw; row < MLAT; row += NGW) {
        v4u cur[4];
#pragma unroll
        for (int j = 0; j < 4; ++j) cur[j] = nx[j];
        if (row + NGW < MLAT) { const GAS v4u* xr = (const GAS v4u*)(F.H + (size_t)(row + NGW) * D) + lane;
#pragma unroll
            for (int j = 0; j < 4; ++j) nx[j] = xr[64 * j]; }
        GAS f32x4* orow = (GAS f32x4*)(F.out + (size_t)row * D) + 2 * lane;
        f32x4 v[4][2]; float s = 0.f;
#pragma unroll
        for (int j = 0; j < 4; ++j) { const v4u w = cur[j]; v[j][0] = (f32x4){bflo(w.x), bfhi(w.x), bflo(w.y), bfhi(w.y)}; v[j][1] = (f32x4){bflo(w.z), bfhi(w.z), bflo(w.w), bfhi(w.w)};
            s += (v[j][0].x * v[j][0].x + v[j][0].y * v[j][0].y) + (v[j][0].z * v[j][0].z + v[j][0].w * v[j][0].w) + (v[j][1].x * v[j][1].x + v[j][1].y * v[j][1].y) + (v[j][1].z * v[j][1].z + v[j][1].w * v[j][1].w); }
        const float r = __builtin_amdgcn_rsqf(wave_sum_dpp(s) * (1.0f / D) + NORM_EPS);
#pragma unroll
        for (int j = 0; j < 4; ++j) { orow[128 * j] = (v[j][0] * r) * g[j][0]; orow[128 * j + 1] = (v[j][1] * r) * g[j][1]; }
    }
}

struct Args { const float* in[18]; float* out; unsigned char* ws; int ph_lo, ph_hi, li, pad; };
__global__ void __launch_bounds__(NWAVES * 64, 2) fwd_kernel(Args args) {
    extern __shared__ __attribute__((aligned(16))) unsigned char lds[];
    Frame F;
    F.lds = (LAS unsigned char*)lds;
    F.MISC = (volatile LAS unsigned*)(F.lds + MISC_OFF);
    F.wave = __builtin_amdgcn_readfirstlane((int)threadIdx.x >> 6);
    F.G = gridDim.x; F.bid = blockIdx.x;
    unsigned char* ws = args.ws;
    F.ctl = (gu32*)(ws + WS_CTL);
    F.x = args.in[0]; F.c = args.in[1]; F.ctx = args.in[2]; F.c_ctx = args.in[3]; F.w_ada = args.in[4]; F.b_ada = args.in[5]; F.norm1_g = args.in[6]; F.w_in = args.in[7]; F.b_gates = args.in[8];
    F.attn_sink = args.in[9]; F.mlstm_norm_g = args.in[10]; F.w_attn_proj = args.in[11]; F.w_mlstm_proj = args.in[12]; F.w_out = args.in[13]; F.norm2_g = args.in[14]; F.w_ffn_in = args.in[15];
    F.w_ffn_out = args.in[16]; F.final_norm_g = args.in[17]; F.out = args.out;
    F.MOD = (float*)(ws + WS_MOD); F.ROPE = (float*)(ws + WS_ROPE); F.MODP = (float*)(ws + WS_MODP); F.GATES = (float*)(ws + WS_GATES); F.GU = (float*)(ws + WS_GU); F.GB = (float*)(ws + WS_GB); F.GS = (float*)(ws + WS_GS);
    F.CKA = (bf16*)(ws + WS_CKA); F.CVA = (bf16*)(ws + WS_CVA); F.CMK = (bf16*)(ws + WS_CMK); F.CMV = (bf16*)(ws + WS_CMV);
    F.WAM = (bf16*)(ws + WS_WAM); F.WOUT = (bf16*)(ws + WS_WOUT); F.WFFI = (bf16*)(ws + WS_WFFI); F.WFFO = (bf16*)(ws + WS_WFFO); F.WIN = (bf16*)(ws + WS_WIN);
    F.H = (bf16*)(ws + WS_H); F.AM = (bf16*)(ws + WS_AM); F.KA = (bf16*)(ws + WS_KA); F.VA = (bf16*)(ws + WS_VA); F.MQ = (bf16*)(ws + WS_MQ); F.MK = (bf16*)(ws + WS_MK); F.MV = (bf16*)(ws + WS_MV);
    F.H0 = (bf16*)(ws + WS_H); F.H1 = (bf16*)(ws + WS_H1); F.Y = (bf16*)(ws + WS_Y); F.HDN = (bf16*)(ws + WS_HDN); F.GG = (bf16*)args.out;
    for (int u = (int)threadIdx.x; u < (LDS_BYTES - LDSCTL_OFF) / 4; u += NWAVES * 64) ((LAS unsigned*)(F.lds + LDSCTL_OFF))[u] = 0u;
    __syncthreads();
    XcdBarrier bar; bar.bar = (unsigned*)(F.ctl + CW_BAR); bar.x = 0; bar.st = nullptr;
    if (N_LAUNCHES == 1) bar = xcd_barrier_post((unsigned*)(F.ctl + CW_BAR), F.MISC + 8);
#define GRID_BAR(seam) do { if (N_LAUNCHES != 1) { if ((int)threadIdx.x == 0) __hip_atomic_store(F.ctl + CW_TMO, 0xBADBA0u | (unsigned)(seam), RLX_AGENT); } else { xcd_barrier(bar); } } while (0)
    const int lo = args.ph_lo, hi = args.ph_hi;
#define IN(k) (lo <= (k) && (k) < hi)
#define BOTH(k) (IN(k) && IN((k) + 1))
    const int gw = F.bid * NWAVES + F.wave, NGW = F.G * NWAVES;

    if (IN(0)) { phase_prologue(F, F.G == 256);
        if (BOTH(0)) GRID_BAR(0); }
    if (IN(1)) { phase_mod_reduce(F); if (BOTH(1)) GRID_BAR(1); }
    if (IN(2)) {
        constexpr int RPW = (MTOT + 2047) / 2048;
        const int rpw = (NGW >= 2048) ? RPW : (MTOT + NGW - 1) / NGW;
        const int r0 = gw * rpw, r1 = (r0 + rpw) < MTOT ? (r0 + rpw) : MTOT;
        norm_mod_rows(F, F.x, r0, r1, F.norm1_g, F.H, 0, 1, true);
        if (BOTH(2)) GRID_BAR(2);
    }
    if (IN(3)) {
        pg8::Gemm g{F.H, F.WIN, D, D, D}; pg8::OrderInProj S{F.G, F.bid};
        EpiInProj E{F.AM, F.KA, F.VA, F.MQ, F.MK, F.MV, F.GG, F.CKA, F.CVA, F.CMK, F.CMV, F.GATES, F.ROPE};
        pg8::gemm_phase<EpiInProj, pg8::OrderInProj, PG8_ALIGN, PG8_SP2, true>(F.lds + RING_OFF, g, S, E);
        if (F.G == 256 && F.bid >= (128 * 53 + 4 * 17) - 26 * 256) convert_ffn_weights_one_batch(F);
        if (BOTH(3)) GRID_BAR(3);
    }
    if (IN(4)) { phase_gate_scan(F); if (BOTH(4)) GRID_BAR(4); }
    if (IN(5)) {
        if (F.G == 256) {
            const int role = (F.bid >> 3) & 1, idx = (F.bid >> 4) * 8 + (F.bid & 7);
            if (role == 0) ml::mlstm_unit_wide(F, idx, lds);
            phase_attn_range(F, lds, idx * 16, role == 0 ? 0 : 10);
            convert_ffn_weights_queue(F);
        } else {
        for (int u0 = F.bid; u0 < 256; u0 += F.G) ml::mlstm_unit(F, u0, lds);
        __syncthreads();
        phase_attn_mfma<true>(F, lds);
        }
        if (BOTH(5)) GRID_BAR(5);
    }
    if (IN(6)) { phase_mem(F); if (BOTH(6)) GRID_BAR(6); }
    if (IN(7)) {
        pg8::Gemm g{F.AM, F.WAM, 4096, 4096, D}; pg8::OrderPair S{128, 8, F.G, F.bid, 2048 * 2};
        EpiMerge E{F.GG, F.Y};
        pg8::gemm_phase<EpiMerge, pg8::OrderPair, PG8_ALIGN, PG8_SP2>(F.lds + RING_OFF, g, S, E);
        if (BOTH(7)) GRID_BAR(7);
    }
    if (IN(8)) {
        pg8::Gemm g{F.Y, F.WOUT, D, D, D}; pg8::OrderPlain S{128, 8, F.G, F.bid};
        EpiResidBf16 E{F.x, (bf16*)F.out, F.MOD + 2 * D};
        pg8::gemm_phase<EpiResidBf16, pg8::OrderPlain, PG8_ALIGN, PG8_SP2, true>(F.lds + RING_OFF, g, S, E);
        if (BOTH(8)) GRID_BAR(8);
    }
    if (IN(9)) {
        const int rpw = (MLAT + NGW - 1) / NGW; const int r0 = gw * rpw, r1 = (r0 + rpw) < MLAT ? (r0 + rpw) : MLAT;
        norm_mod_rows_b(F, (const bf16*)F.out, r0, r1, F.norm2_g, F.H, 3, 4);
        if (BOTH(9)) GRID_BAR(9);
    }
    if (IN(10)) {
        pg8::Gemm g{F.H, F.WFFI, D, D, D}; pg8::OrderPlain S{128, 44, F.G, F.bid};
        EpiSwiGLU E{F.HDN};
        pg8::gemm_phase<EpiSwiGLU, pg8::OrderPlain, PG8_ALIGN, PG8_SP2, true>(F.lds + RING_OFF, g, S, E);
        if (BOTH(10)) GRID_BAR(10);
    }
    if (IN(11)) {
        pg8::Gemm g{F.HDN, F.WFFO, DFF, DFF, DFF}; pg8::OrderPlain S{128, 8, F.G, F.bid};
        EpiResidBB E{(const bf16*)F.out, F.H, F.MOD + 5 * D};
        pg8::gemm_phase<EpiResidBB, pg8::OrderPlain, PG8_ALIGN, PG8_SP2, true>(F.lds + RING_OFF, g, S, E);
        if (BOTH(11)) GRID_BAR(11);
    }
    if (IN(12)) { phase_final_norm(F); }
#undef IN
#undef BOTH
}

extern "C" void kernel_launch(void* const* d_in, const int* in_sizes, int n_in, void* d_out, int out_size, void* d_ws, size_t ws_size, hipStream_t stream) {
    static int grid = 0;
    if (grid == 0) {
        if (n_in != 18 || in_sizes[0] != MLAT * D || out_size != MLAT * D || ws_size < WS_END) { fprintf(stderr, "kernel_launch: unexpected shapes (n_in %d, in0 %d, out %d, ws %zu)\n", n_in, n_in > 0 ? in_sizes[0] : -1, out_size, ws_size); grid = -1; return; }
        int dev = 0, cus = 0, per_cu = 0;
        if (hipGetDevice(&dev) != hipSuccess || hipDeviceGetAttribute(&cus, hipDeviceAttributeMultiprocessorCount, dev) != hipSuccess) { grid = -1; return; }
        if (hipFuncSetAttribute((const void*)fwd_kernel, hipFuncAttributeMaxDynamicSharedMemorySize, LDS_BYTES) != hipSuccess) { fprintf(stderr, "kernel_launch: hipFuncSetAttribute failed\n"); grid = -1; return; }
        if (hipOccupancyMaxActiveBlocksPerMultiprocessor(&per_cu, (const void*)fwd_kernel, NWAVES * 64, LDS_BYTES) != hipSuccess || per_cu < 1)
            fprintf(stderr, "kernel_launch: note: occupancy query reports %d workgroups per CU\n", per_cu);
        (void)hipGetLastError();
        grid = cus;
    }
    if (grid < 0) return;
    if (hipMemsetAsync((char*)d_ws + WS_CTL, 0, CTL_ZERO_BYTES, stream) != hipSuccess) return;
    Args a{};
    for (int i = 0; i < 18; ++i) a.in[i] = (const float*)d_in[i];
    a.out = (float*)d_out; a.ws = (unsigned char*)d_ws;
    for (int li = 0; li < N_LAUNCHES; ++li) {
        a.ph_lo = (N_LAUNCHES == 1) ? 0 : li; a.ph_hi = (N_LAUNCHES == 1) ? N_PHASES : li + 1; a.li = li; a.pad = 0;
        hipLaunchKernelGGL(fwd_kernel, dim3(grid), dim3(NWAVES * 64), LDS_BYTES, stream, a);
        if (hipPeekAtLastError() != hipSuccess) { fprintf(stderr, "kernel_launch: launch %d failed\n", li); break; }
    }
}
```
